# Optimizing an MI355X kernel written in HIP

```python
import jax, jax.numpy as jnp
from jax import lax
import numpy as np

D_MODEL = 1024
BATCH = 2
SEQ = 16384
DEPTH = 2
DEC_BATCH = 4
DEC_SEQ = 4096
PAST_LEN = 128

GRID_W = 64
Q_BLOCK = 128
ROPE_THETA = 10000.0
NORM_EPS = 1e-6
MLA_HEADS = 4
MLA_Q_LORA = 384
MLA_KV_LORA = 256
MLA_NOPE = 128
MLA_ROPE = 64
MLA_V = 128
GQA_HEADS = 4
GQA_KV_HEADS = 2
GQA_HEAD_DIM = 128
MIX_WIDTH = MLA_HEADS * MLA_V + GQA_HEADS * GQA_HEAD_DIM
D_FF = 4 * D_MODEL
IN_SPLITS = (MLA_Q_LORA, MLA_KV_LORA, MLA_ROPE,
             GQA_HEADS * GQA_HEAD_DIM, GQA_KV_HEADS * GQA_HEAD_DIM, GQA_KV_HEADS * GQA_HEAD_DIM)
IN_WIDTH = sum(IN_SPLITS)
IN_OFFSETS = [int(o) for o in np.cumsum(IN_SPLITS)[:-1]]

kernel_name = "hymba_mla_gqa_axial_encoder"


def rmsnorm(x, g):
    x32 = x.astype(jnp.float32)
    y = x32 * lax.rsqrt(jnp.mean(x32 * x32, axis=-1, keepdims=True) + NORM_EPS)
    return (y * g.astype(jnp.float32)).astype(x.dtype)


def rope1d(x, pos):
    d = x.shape[-1]
    freqs = ROPE_THETA ** (-jnp.arange(0, d, 2, dtype=jnp.float32) / d)
    ang = pos.astype(jnp.float32)[:, None] * freqs[None, :]
    cos = jnp.cos(ang)[None, :, None, :]
    sin = jnp.sin(ang)[None, :, None, :]
    x32 = x.astype(jnp.float32)
    x1, x2 = x32[..., : d // 2], x32[..., d // 2:]
    return jnp.concatenate([x1 * cos - x2 * sin, x2 * cos + x1 * sin], axis=-1)


def axial_rope(x, rows):
    half = x.shape[-1] // 2
    row_pos = jnp.repeat(jnp.arange(rows), GRID_W)
    col_pos = jnp.tile(jnp.arange(GRID_W), rows)
    out = jnp.concatenate([rope1d(x[..., :half], row_pos), rope1d(x[..., half:], col_pos)], axis=-1)
    return out.astype(x.dtype)


def block_attention(q, k, v, scale):
    B, S, Hk, G, D = q.shape
    nb = S // Q_BLOCK
    qb = q.reshape(B, nb, Q_BLOCK, Hk, G, D).transpose(1, 0, 2, 3, 4, 5)

    def one_block(qblk):
        s = jnp.einsum('bqhgd,bkhd->bhgqk', qblk, k, preferred_element_type=jnp.float32) * scale
        p = jax.nn.softmax(s, axis=-1).astype(v.dtype)
        return jnp.einsum('bhgqk,bkhd->bqhgd', p, v)

    o = lax.map(one_block, qb)
    return o.transpose(1, 0, 2, 3, 4, 5).reshape(B, S, Hk * G, v.shape[-1])


def encoder_layer(x, attn_norm, w_in, mla_q_norm, w_mla_q_up, mla_kv_norm, w_mla_kv_up,
                  gqa_q_norm, gqa_k_norm, w_out, mlp_norm, w_mlp_up, w_mlp_down):
    B, S, _ = x.shape
    rows = S // GRID_W
    h = rmsnorm(x, attn_norm)
    z = h @ w_in
    cq, ckv, k_rope_raw, qb, kb, vb = jnp.split(z, IN_OFFSETS, axis=-1)

    qa = (rmsnorm(cq, mla_q_norm) @ w_mla_q_up).reshape(B, S, MLA_HEADS, MLA_NOPE + MLA_ROPE)
    qa_nope, qa_rope = qa[..., :MLA_NOPE], axial_rope(qa[..., MLA_NOPE:], rows)
    kva = (rmsnorm(ckv, mla_kv_norm) @ w_mla_kv_up).reshape(B, S, MLA_HEADS, MLA_NOPE + MLA_V)
    ka_nope, va = kva[..., :MLA_NOPE], kva[..., MLA_NOPE:]
    ka_rope = axial_rope(k_rope_raw.reshape(B, S, 1, MLA_ROPE), rows)
    q_a = jnp.concatenate([qa_nope, qa_rope], axis=-1)[:, :, :, None, :]
    k_a = jnp.concatenate([ka_nope, jnp.broadcast_to(ka_rope, (B, S, MLA_HEADS, MLA_ROPE))], axis=-1)
    o_a = block_attention(q_a, k_a, va, (MLA_NOPE + MLA_ROPE) ** -0.5)
    o_a = o_a.reshape(B, S, MLA_HEADS * MLA_V)

    q_b = axial_rope(rmsnorm(qb.reshape(B, S, GQA_HEADS, GQA_HEAD_DIM), gqa_q_norm), rows)
    k_b = axial_rope(rmsnorm(kb.reshape(B, S, GQA_KV_HEADS, GQA_HEAD_DIM), gqa_k_norm), rows)
    v_b = vb.reshape(B, S, GQA_KV_HEADS, GQA_HEAD_DIM)
    q_b = q_b.reshape(B, S, GQA_KV_HEADS, GQA_HEADS // GQA_KV_HEADS, GQA_HEAD_DIM)
    o_b = block_attention(q_b, k_b, v_b, GQA_HEAD_DIM ** -0.5).reshape(B, S, GQA_HEADS * GQA_HEAD_DIM)

    x = x + jnp.concatenate([o_a, o_b], axis=-1) @ w_out

    u = rmsnorm(x, mlp_norm) @ w_mlp_up
    x = x + jnp.square(jax.nn.relu(u)) @ w_mlp_down
    return x


def trunk(x, attn_norm, w_in, mla_q_norm, w_mla_q_up, mla_kv_norm, w_mla_kv_up,
          gqa_q_norm, gqa_k_norm, w_out, mlp_norm, w_mlp_up, w_mlp_down, final_norm):
    for l in range(DEPTH):
        x = encoder_layer(x, attn_norm[l], w_in[l], mla_q_norm[l], w_mla_q_up[l], mla_kv_norm[l],
                          w_mla_kv_up[l], gqa_q_norm[l], gqa_k_norm[l], w_out[l], mlp_norm[l],
                          w_mlp_up[l], w_mlp_down[l])
    return rmsnorm(x, final_norm)


def setup_inputs(seed: int = 0) -> dict:
    key = jax.random.key(seed)
    ks = jax.random.split(key, 16)

    def w(k, shape):
        return jax.random.normal(k, shape, jnp.float32) * (shape[-2] ** -0.5)

    def gain(k, shape):
        return 1.0 + 0.01 * jax.random.normal(k, shape, jnp.float32)

    return {
        "x_prompt": jax.random.normal(ks[0], (BATCH, SEQ, D_MODEL), jnp.float32),
        "x_sample": jax.random.normal(ks[1], (DEC_BATCH, DEC_SEQ, D_MODEL), jnp.float32),
        "attn_norm": gain(ks[2], (DEPTH, D_MODEL)),
        "w_in": w(ks[3], (DEPTH, D_MODEL, IN_WIDTH)),
        "mla_q_norm": gain(ks[4], (DEPTH, MLA_Q_LORA)),
        "w_mla_q_up": w(ks[5], (DEPTH, MLA_Q_LORA, MLA_HEADS * (MLA_NOPE + MLA_ROPE))),
        "mla_kv_norm": gain(ks[6], (DEPTH, MLA_KV_LORA)),
        "w_mla_kv_up": w(ks[7], (DEPTH, MLA_KV_LORA, MLA_HEADS * (MLA_NOPE + MLA_V))),
        "gqa_q_norm": gain(ks[8], (DEPTH, GQA_HEAD_DIM)),
        "gqa_k_norm": gain(ks[9], (DEPTH, GQA_HEAD_DIM)),
        "w_out": w(ks[10], (DEPTH, MIX_WIDTH, D_MODEL)),
        "mlp_norm": gain(ks[11], (DEPTH, D_MODEL)),
        "w_mlp_up": w(ks[12], (DEPTH, D_MODEL, D_FF)),
        "w_mlp_down": w(ks[13], (DEPTH, D_FF, D_MODEL)),
        "final_norm": gain(ks[14], (D_MODEL,)),
    }


def reference(x_prompt, x_sample, attn_norm, w_in, mla_q_norm, w_mla_q_up, mla_kv_norm, w_mla_kv_up,
              gqa_q_norm, gqa_k_norm, w_out, mlp_norm, w_mlp_up, w_mlp_down, final_norm):
    y_prompt = trunk(x_prompt, attn_norm, w_in, mla_q_norm, w_mla_q_up, mla_kv_norm, w_mla_kv_up,
                     gqa_q_norm, gqa_k_norm, w_out, mlp_norm, w_mlp_up, w_mlp_down, final_norm)
    y_sample = trunk(x_sample, attn_norm, w_in, mla_q_norm, w_mla_q_up, mla_kv_norm, w_mla_kv_up,
                     gqa_q_norm, gqa_k_norm, w_out, mlp_norm, w_mlp_up, w_mlp_down, final_norm)
    return (y_prompt, y_sample)
```

```cpp
#include <hip/hip_runtime.h>
#include <hip/hip_cooperative_groups.h>
#include <cstdio>
#include <cstdint>
namespace cg = cooperative_groups;

#ifndef MK_PER_PHASE
#define MK_PER_PHASE 0
#endif

#ifndef REP_ATTN
#define REP_ATTN 1
#endif
#ifndef REP_THIN
#define REP_THIN 1
#endif
#define LAS __attribute__((address_space(3)))
#define GAS __attribute__((address_space(1)))
typedef unsigned short bf16_t;
typedef short bf16x8 __attribute__((ext_vector_type(8)));
typedef short s16x4 __attribute__((ext_vector_type(4)));
typedef float f32x4 __attribute__((ext_vector_type(4)));
typedef float f32x16 __attribute__((ext_vector_type(16)));
typedef unsigned u32x4 __attribute__((ext_vector_type(4)));
typedef unsigned u32x2 __attribute__((ext_vector_type(2)));

constexpr int DM = 1024, T_PROMPT = 2 * 16384, T_SAMPLE = 4 * 4096, T = T_PROMPT + T_SAMPLE;
constexpr int S_PROMPT = 16384, S_SAMPLE = 4096;
constexpr int DEPTH = 2;
constexpr int QLORA = 384, KVLORA = 256, NOPE = 128, ROPE = 64, VD = 128, HD = 128;
constexpr int INW = 1728, INW_PAD = 1792, DFF = 4096;
constexpr int QA_W = 4 * (NOPE + ROPE)  , KVA_W = 4 * (NOPE + VD)  ;
constexpr float EPS = 1e-6f;
constexpr float LOG2_THETA = 13.287712379549449f;
constexpr float INV_2PI = 0.15915494309189535f;

constexpr size_t W_IN = 0, W_Q = W_IN + (size_t)INW_PAD * DM * 2, W_KV = W_Q + (size_t)QA_W * QLORA * 2, W_O = W_KV + (size_t)KVA_W * KVLORA * 2,
                 W_UP = W_O + (size_t)DM * DM * 2, W_DN = W_UP + (size_t)DFF * DM * 2, W_END = W_DN + (size_t)DM * DFF * 2;
constexpr size_t AR = (W_END + 255) / 256 * 256;
constexpr size_t A_Z = AR, A_QA = A_Z, A_KVA = A_QA + (size_t)T * QA_W * 2;
constexpr size_t A_O = A_Z + (size_t)T * INW_PAD * 2, A_H = A_O;
constexpr size_t A_CQN = A_O + (size_t)T * DM * 2, A_CKVN = A_CQN + (size_t)T * QLORA * 2, A_KR = A_CKVN + (size_t)T * KVLORA * 2,
                 A_QB = A_KR + (size_t)T * ROPE * 2, A_KB = A_QB + (size_t)T * 512 * 2, A_VB = A_KB + (size_t)T * 256 * 2, A_END1 = A_VB + (size_t)T * 256 * 2;
constexpr size_t A_H2 = AR, A_U = A_H2 + (size_t)T * DM * 2, A_END2 = A_U + (size_t)T * DFF * 2;
constexpr size_t WS_NEED = A_END1 > A_END2 ? A_END1 : A_END2;
static_assert(A_KVA + (size_t)T * KVA_W * 2 == A_O, "QA|KVA must overlay Z exactly");

constexpr int LDS_XB = 131072;
constexpr int LDS_BYTES = 131072 + 16;
constexpr size_t WS_BAR = (WS_NEED + 255) / 256 * 256, WS_RS = WS_BAR + 16384, WS_RS2 = WS_RS + (size_t)T * 16 * 4, WS_TOTAL = WS_RS2 + (size_t)T * 16 * 4;
constexpr size_t WS_SLOTS = WS_BAR + 3456 * 4;
constexpr int NWAVES = 8;

__device__ __forceinline__ unsigned cvt_pk_bf16(float lo, float hi) { unsigned r; asm volatile("v_cvt_pk_bf16_f32 %0, %1, %2" : "=v"(r) : "v"(lo), "v"(hi)); return r; }
__device__ __forceinline__ bf16_t f2bf(float f) { unsigned u = __float_as_uint(f); u += 0x7FFFu + ((u >> 16) & 1u); return (bf16_t)(u >> 16); }
__device__ __forceinline__ float bf2f(bf16_t b) { return __uint_as_float(((unsigned)b) << 16); }
__device__ __forceinline__ int lane_opaque() { unsigned z = 0u; asm volatile("" : "+v"(z)); return (int)__builtin_amdgcn_mbcnt_hi(~0u, __builtin_amdgcn_mbcnt_lo(~0u, z)); }
__device__ __forceinline__ float shx(float v, int o, int l) { return __int_as_float(__builtin_amdgcn_ds_bpermute((l ^ o) << 2, __float_as_int(v))); }
__device__ __forceinline__ float wave_sum(float v) {
    const int l = lane_opaque();
#pragma unroll
    for (int o = 1; o < 64; o <<= 1) v += shx(v, o, l);
    return v;
}
__device__ __forceinline__ int seq_pos(int tok) { return tok < T_PROMPT ? (tok & (S_PROMPT - 1)) : (tok & (S_SAMPLE - 1)); }
__device__ __forceinline__ void sincos_hw(float ang, float& s, float& c) { const float r = ang * INV_2PI; s = __builtin_amdgcn_sinf(r); c = __builtin_amdgcn_cosf(r); }

namespace pg8 {
constexpr int BM = 256, BK = 64, HALF = 128, HTB = HALF * BK * 2, STAGE_BYTES = 8 * HTB, NXCD = 8, WGM = 8;
__host__ __device__ __forceinline__ int lds_byte(int r, int c) { const int st = (r >> 4) * 2 + (c >> 5), rr = r & 15, cc = c & 31, ob = rr * 64 + cc * 2; return st * 1024 + (ob ^ (((ob >> 9) & 1) << 5)); }
__host__ __device__ __forceinline__ void stage_rc(int b, int& R, int& C) { const int st = b / 1024, sb = b % 1024, swz = sb ^ (((sb >> 9) & 1) << 5); R = (st >> 1) * 16 + swz / 64; C = (st & 1) * 32 + (swz % 64) / 2; }
__host__ __device__ __forceinline__ int perm32(int rho) { const int n = rho >> 4, i = rho & 15; return 8 * (i >> 2) + 4 * n + (i & 3); }
struct Unit { int pm, pn; };
struct Gemm { const bf16_t* A; const bf16_t* Bt; int M, N, K; };
struct StaticOrder {
    int nM, nN, nwg, G, c;
    __device__ void init(int M, int N, int G_, int c_) { nM = M / BM; nN = N / BM; nwg = nM * nN; G = G_; c = c_; }
    __device__ bool next(int i, Unit& u) const {
        const long L = (long)i * G + c; if (L >= nwg) return false;
        int wgid = (int)L; { const int q = nwg / NXCD, r = nwg % NXCD, xcd = wgid % NXCD, off = wgid / NXCD; wgid = (xcd < r ? xcd * (q + 1) : r * (q + 1) + (xcd - r) * q) + off; }
        const int nig = WGM * nN, gid = wgid / nig, fm = gid * WGM, gsz = (nM - fm) < WGM ? (nM - fm) : WGM;
        u.pm = fm + ((wgid % nig) % gsz); u.pn = (wgid % nig) / gsz; return true;
    }
};
template <int ACT  > struct EpiBf16 {
    static constexpr bool PERM = true;
    bf16_t* O; int ldc; const float* rs;
    __device__ __forceinline__ void operator()(const f32x4 (&acc)[2][2][4][2], const Unit& u, int wr, int wc, int fr, int fq) const {
        const int row0 = u.pm * BM + wr * 64 + fr, col0 = u.pn * BM + wc * 32 + 8 * fq;
#pragma unroll
        for (int ai = 0; ai < 2; ++ai)
#pragma unroll
            for (int m = 0; m < 4; ++m) { bf16_t* rowp = O + (size_t)(row0 + ai * HALF + m * 16) * ldc + col0;
                const float sc = rs ? rs[row0 + ai * HALF + m * 16] : 1.f;
#pragma unroll
                for (int bj = 0; bj < 2; ++bj) { f32x4 v0 = acc[ai][bj][m][0] * sc, v1 = acc[ai][bj][m][1] * sc;
                    if (ACT == 1) {
#pragma unroll
                        for (int j = 0; j < 4; ++j) { const float a = fmaxf(v0[j], 0.f), b = fmaxf(v1[j], 0.f); v0[j] = a * a; v1[j] = b * b; } }
                    u32x4 w; w.x = cvt_pk_bf16(v0[0], v0[1]); w.y = cvt_pk_bf16(v0[2], v0[3]); w.z = cvt_pk_bf16(v1[0], v1[1]); w.w = cvt_pk_bf16(v1[2], v1[3]);
                    *(u32x4*)(rowp + bj * HALF) = w; } }
    }
};
struct EpiZ {
    static constexpr bool PERM = true;
    bf16_t* Z; bf16_t* VB; const float* rs; bool vb_direct;
    __device__ __forceinline__ void operator()(const f32x4 (&acc)[2][2][4][2], const Unit& u, int wr, int wc, int fr, int fq) const {
        const int row0 = u.pm * BM + wr * 64 + fr;
#pragma unroll
        for (int bj = 0; bj < 2; ++bj) {
            const int g0 = u.pn * BM + bj * HALF + wc * 32;
            const bool tovb = vb_direct && g0 >= 1472;
            bf16_t* base = tovb ? VB + (g0 - 1472) + 8 * fq : Z + g0 + 8 * fq; const int ld = tovb ? 256 : INW_PAD;
            if (g0 < INW) {
#pragma unroll
                for (int ai = 0; ai < 2; ++ai)
#pragma unroll
                    for (int m = 0; m < 4; ++m) { const float sc = rs ? rs[row0 + ai * HALF + m * 16] : 1.f; const f32x4 v0 = acc[ai][bj][m][0] * sc, v1 = acc[ai][bj][m][1] * sc;
                        u32x4 w; w.x = cvt_pk_bf16(v0[0], v0[1]); w.y = cvt_pk_bf16(v0[2], v0[3]); w.z = cvt_pk_bf16(v1[0], v1[1]); w.w = cvt_pk_bf16(v1[2], v1[3]);
                        *(u32x4*)(base + (size_t)(row0 + ai * HALF + m * 16) * ld) = w; } }
        }
    }
};
struct EpiBf16Norm {
    static constexpr bool PERM = true;
    bf16_t* O; int ldc; unsigned* slots; int mode;
    __device__ __forceinline__ void operator()(const f32x4 (&acc)[2][2][4][2], const Unit& u, int wr, int wc, int fr, int fq) const {
        const int row0 = u.pm * BM + wr * 64 + fr, col0 = u.pn * BM + wc * 32 + 8 * fq; const int ln = lane_opaque();
#pragma unroll
        for (int bj = 0; bj < 2; ++bj) {
            float mx = 0.f;
#pragma unroll
            for (int ai = 0; ai < 2; ++ai)
#pragma unroll
                for (int m = 0; m < 4; ++m) { const f32x4 v0 = acc[ai][bj][m][0], v1 = acc[ai][bj][m][1];
                    float ss = (v0[0] * v0[0] + v0[1] * v0[1]) + (v0[2] * v0[2] + v0[3] * v0[3]) + (v1[0] * v1[0] + v1[1] * v1[1]) + (v1[2] * v1[2] + v1[3] * v1[3]);
                    ss += shx(ss, 16, ln); ss += shx(ss, 32, ln); mx = fmaxf(mx, ss);
                    u32x4 w; w.x = cvt_pk_bf16(v0[0], v0[1]); w.y = cvt_pk_bf16(v0[2], v0[3]); w.z = cvt_pk_bf16(v1[0], v1[1]); w.w = cvt_pk_bf16(v1[2], v1[3]);
                    *(u32x4*)(O + (size_t)(row0 + ai * HALF + m * 16) * ldc + col0 + bj * HALF) = w; }
#pragma unroll
            for (int o = 1; o < 16; o <<= 1) mx = fmaxf(mx, shx(mx, o, ln));
            const int g0 = u.pn * BM + bj * HALF + wc * 32;
            const int slot = mode == 0 ? (g0 / 192) * 6 + (g0 % 192) / 32 : 24 + u.pn * 4 + wc;
            if (fr == 0 && fq == 0 && (mode == 0 || bj == 0)) atomicMax(slots + slot, __float_as_uint(mx));
        }
    }
};
template <bool RES_F32> struct EpiResB16 {
    static constexpr bool PERM = true;
    bf16_t* out; const void* res_lo; const void* res_hi; int split; int ldc;
    const float* st_in;
    float* st_out;
    __device__ __forceinline__ void operator()(const f32x4 (&acc)[2][2][4][2], const Unit& u, int wr, int wc, int fr, int fq) const {
        const int row0 = u.pm * BM + wr * 64 + fr, col0 = u.pn * BM + wc * 32 + 8 * fq;
#pragma unroll
        for (int ai = 0; ai < 2; ++ai)
#pragma unroll
            for (int m = 0; m < 4; ++m) { const int row = row0 + ai * HALF + m * 16; float sc = 1.f;
                if (st_in) { const f32x4* sp = (const f32x4*)(st_in + (size_t)row * 16); const f32x4 a = sp[0], b = sp[1], c = sp[2], d = sp[3];
                    const float ssum = ((a[0] + a[1]) + (a[2] + a[3])) + ((b[0] + b[1]) + (b[2] + b[3])) + ((c[0] + c[1]) + (c[2] + c[3])) + ((d[0] + d[1]) + (d[2] + d[3]));
                    sc = 1.f / (ssum * (1.f / 1024.f) + 1e-6f); }
                float ssq = 0.f;
#pragma unroll
                for (int bj = 0; bj < 2; ++bj) { f32x4 v0 = acc[ai][bj][m][0] * sc, v1 = acc[ai][bj][m][1] * sc;
                    if constexpr (RES_F32) { const float* rp = (row < split ? (const float*)res_lo + (size_t)row * ldc : (const float*)res_hi + (size_t)(row - split) * ldc) + col0 + bj * HALF;
                        v0 += *(const f32x4*)rp; v1 += *(const f32x4*)(rp + 4); }
                    else { const u32x4 r = *(const u32x4*)((const bf16_t*)res_lo + (size_t)row * ldc + col0 + bj * HALF);
                        v0[0] += __uint_as_float(r.x << 16); v0[1] += __uint_as_float(r.x & 0xffff0000u); v0[2] += __uint_as_float(r.y << 16); v0[3] += __uint_as_float(r.y & 0xffff0000u);
                        v1[0] += __uint_as_float(r.z << 16); v1[1] += __uint_as_float(r.z & 0xffff0000u); v1[2] += __uint_as_float(r.w << 16); v1[3] += __uint_as_float(r.w & 0xffff0000u); }
                    u32x4 w; w.x = cvt_pk_bf16(v0[0], v0[1]); w.y = cvt_pk_bf16(v0[2], v0[3]); w.z = cvt_pk_bf16(v1[0], v1[1]); w.w = cvt_pk_bf16(v1[2], v1[3]);
                    *(u32x4*)(out + (size_t)row * ldc + col0 + bj * HALF) = w;
                    ssq += ((v0[0] * v0[0] + v0[1] * v0[1]) + (v0[2] * v0[2] + v0[3] * v0[3])) + ((v1[0] * v1[0] + v1[1] * v1[1]) + (v1[2] * v1[2] + v1[3] * v1[3])); }
                if (st_out) { const int ln = lane_opaque(); ssq += shx(ssq, 16, ln); ssq += shx(ssq, 32, ln);
                    if (fq == 0) st_out[(size_t)row * 16 + u.pn * 4 + wc] = ssq; } }
    }
};
struct EpiResF32 {
    static constexpr bool PERM = false;
    float* C; const float* res_lo; const float* res_hi; int split; int ldc;
    __device__ __forceinline__ void operator()(const f32x4 (&acc)[2][2][4][2], const Unit& u, int wr, int wc, int fr, int fq) const {
        const int row0 = u.pm * BM + wr * 64 + fr, col0 = u.pn * BM + wc * 32 + 4 * fq;
#pragma unroll
        for (int ai = 0; ai < 2; ++ai)
#pragma unroll
            for (int m = 0; m < 4; ++m) { const int row = row0 + ai * HALF + m * 16;
                const float* rp = (row < split ? res_lo + (size_t)row * ldc : res_hi + (size_t)(row - split) * ldc) + col0;
                float* rowp = C + (size_t)row * ldc + col0;
#pragma unroll
                for (int bj = 0; bj < 2; ++bj)
#pragma unroll
                    for (int n = 0; n < 2; ++n) { const f32x4 r = *(const f32x4*)(rp + bj * HALF + n * 16); *(f32x4*)(rowp + bj * HALF + n * 16) = acc[ai][bj][m][n] + r; } }
    }
};
template <class Epi, class Sched>
__device__ __forceinline__ void gemm_phase(LAS unsigned char* lds, const Gemm g, const Sched& S, const Epi& E) {
    int tid_ = threadIdx.x; asm volatile("" : "+v"(tid_));
    const int tid = tid_, wid = __builtin_amdgcn_readfirstlane(tid >> 6), lane = tid & 63, wr = wid >> 2, wc = wid & 3, fr = lane & 15, fq = lane >> 4;
    const int K = g.K, nt = K / BK;
    unsigned voffA[2], voffB[2];
#pragma unroll
    for (int i = 0; i < 2; ++i) { int R, C; stage_rc(tid * 16 + i * 8192, R, C); const int Rb = Epi::PERM ? ((R & ~31) + perm32(R & 31)) : R;
        voffA[i] = (unsigned)(R * K + C) * 2u; voffB[i] = (unsigned)(Rb * K + C) * 2u; }
    const size_t kstep = (size_t)(BK * 2);
    const size_t hstep = (size_t)HALF * K * 2;
    const size_t tstep = 2 * hstep;
    const unsigned ldsw = (unsigned)wid * 1024u;
    const int aoff = lds_byte(wr * 64 + fr, fq * 8), boff = lds_byte(wc * 32 + fr, fq * 8);
#define PG8_SA(b, h) (((b) * 2 + (h)) * HTB)
#define PG8_SB(b, h) ((4 + (b) * 2 + (h)) * HTB)
#define PG8_STAGE(bufoff, gbase, voff) do { _Pragma("unroll") for (int _i = 0; _i < 2; ++_i) \
        __builtin_amdgcn_global_load_lds((const unsigned*)((const char*)(gbase) + (voff)[_i]), (LAS unsigned*)(lds + (bufoff) + ldsw + _i * 8192), 16, 0, 0); } while (0)
#define PG8_LDA(dst, b, h) do { _Pragma("unroll") for (int m = 0; m < 4; ++m) _Pragma("unroll") for (int k = 0; k < 2; ++k) dst[m][k] = *(const LAS bf16x8*)(lds + PG8_SA(b, h) + aoff + m * 2048 + k * 1024); } while (0)
#define PG8_LDB(dst, b, h) do { _Pragma("unroll") for (int n = 0; n < 2; ++n) _Pragma("unroll") for (int k = 0; k < 2; ++k) dst[n][k] = *(const LAS bf16x8*)(lds + PG8_SB(b, h) + boff + n * 2048 + k * 1024); } while (0)
#define PG8_MMA(ai, bj, At, Bt) do { __builtin_amdgcn_s_setprio(1); _Pragma("unroll") for (int m = 0; m < 4; ++m) _Pragma("unroll") for (int n = 0; n < 2; ++n) _Pragma("unroll") for (int k = 0; k < 2; ++k) \
        acc[ai][bj][m][n] = __builtin_amdgcn_mfma_f32_16x16x32_bf16(Bt[n][k], At[m][k], acc[ai][bj][m][n], 0, 0, 0); __builtin_amdgcn_s_setprio(0); } while (0)
#define PG8_WAIT_V(n) asm volatile("s_waitcnt vmcnt(" #n ")" ::: "memory")
#define PG8_WAIT_L(n) asm volatile("s_waitcnt lgkmcnt(" #n ")" ::: "memory")
#define PG8_BAR __builtin_amdgcn_s_barrier()
#define PG8_SCHED __builtin_amdgcn_sched_barrier(0)
    Unit cur, nxt; int ui = 0;
    if (!S.next(0, cur)) return;
    f32x4 acc[2][2][4][2];
#pragma unroll
    for (int a = 0; a < 2; ++a)
#pragma unroll
        for (int b = 0; b < 2; ++b)
#pragma unroll
            for (int m = 0; m < 4; ++m)
#pragma unroll
                for (int n = 0; n < 2; ++n) acc[a][b][m][n] = (f32x4){0.f, 0.f, 0.f, 0.f};
    bf16x8 At[4][2], B0[2][2], B1[2][2];
    const char* cA = (const char*)g.A + (size_t)cur.pm * tstep; const char* cB = (const char*)g.Bt + (size_t)cur.pn * tstep;
    PG8_STAGE(PG8_SB(0, 0), cB, voffB); PG8_STAGE(PG8_SB(0, 1), cB + hstep, voffB); PG8_STAGE(PG8_SA(0, 0), cA, voffA); PG8_STAGE(PG8_SA(0, 1), cA + hstep, voffA);
    if (wr == 1) PG8_BAR;
    PG8_WAIT_V(2); PG8_BAR;
    PG8_STAGE(PG8_SB(1, 0), cB + kstep, voffB); PG8_STAGE(PG8_SA(1, 0), cA + kstep, voffA); PG8_STAGE(PG8_SB(1, 1), cB + hstep + kstep, voffB);
    PG8_WAIT_V(6); PG8_BAR;
    for (;;) {
        const bool has_next = S.next(ui + 1, nxt);
        const char* nA = has_next ? (const char*)g.A + (size_t)nxt.pm * tstep : cA; const char* nB = has_next ? (const char*)g.Bt + (size_t)nxt.pn * tstep : cB;
        for (int t = 0; t < nt; t += 2) {
            const bool last = (t == nt - 2);
            const char* a1 = cA + (size_t)(t + 1) * kstep;
            const char* a2 = last ? nA : cA + (size_t)(t + 2) * kstep; const char* b2 = last ? nB : cB + (size_t)(t + 2) * kstep;
            const char* a3 = a2 + kstep; const char* b3 = b2 + kstep;
            PG8_LDB(B0, 0, 0); PG8_LDB(B1, 0, 1); PG8_SCHED; PG8_LDA(At, 0, 0); PG8_STAGE(PG8_SA(1, 1), a1 + hstep, voffA);
            PG8_WAIT_V(8); PG8_WAIT_L(0); PG8_BAR; PG8_MMA(0, 0, At, B0); PG8_MMA(0, 1, At, B1); PG8_BAR; PG8_SCHED;
            PG8_LDA(At, 0, 1); PG8_STAGE(PG8_SB(0, 0), b2, voffB); PG8_STAGE(PG8_SB(0, 1), b2 + hstep, voffB); PG8_STAGE(PG8_SA(0, 0), a2, voffA);
            PG8_WAIT_V(8); PG8_WAIT_L(0); PG8_BAR; PG8_MMA(1, 0, At, B0); PG8_MMA(1, 1, At, B1); PG8_BAR; PG8_SCHED;
            PG8_LDB(B0, 1, 0); PG8_LDB(B1, 1, 1); PG8_SCHED; PG8_LDA(At, 1, 0); PG8_STAGE(PG8_SA(0, 1), a2 + hstep, voffA);
            PG8_WAIT_V(8); PG8_WAIT_L(0); PG8_BAR; PG8_MMA(0, 0, At, B0); PG8_MMA(0, 1, At, B1); PG8_BAR; PG8_SCHED;
            PG8_LDA(At, 1, 1); PG8_STAGE(PG8_SB(1, 0), b3, voffB); PG8_STAGE(PG8_SB(1, 1), b3 + hstep, voffB); PG8_STAGE(PG8_SA(1, 0), a3, voffA);
            PG8_WAIT_V(8); PG8_WAIT_L(0); PG8_BAR; PG8_MMA(1, 0, At, B0); PG8_MMA(1, 1, At, B1); PG8_BAR; PG8_SCHED;
        }
        if (wr == 0) PG8_BAR;
        E(acc, cur, wr, wc, fr, fq);
        if (!has_next) break;
#pragma unroll
        for (int a = 0; a < 2; ++a)
#pragma unroll
            for (int b = 0; b < 2; ++b)
#pragma unroll
                for (int m = 0; m < 4; ++m)
#pragma unroll
                    for (int n = 0; n < 2; ++n) acc[a][b][m][n] = (f32x4){0.f, 0.f, 0.f, 0.f};
        cur = nxt; cA = nA; cB = nB; ++ui;
        if (wr == 1) PG8_BAR;
    }
    PG8_WAIT_V(0);
    PG8_BAR;
#undef PG8_SA
#undef PG8_SB
#undef PG8_STAGE
#undef PG8_LDA
#undef PG8_LDB
#undef PG8_MMA
#undef PG8_WAIT_V
#undef PG8_WAIT_L
#undef PG8_BAR
#undef PG8_SCHED
}
}

namespace att {
constexpr int NW = 8, QBLK = 32, KVBLK = 64;
constexpr float THR = 8.f;
#define SBAR() __builtin_amdgcn_sched_barrier(0)
__device__ __forceinline__ int crow(int r, int hi) { return (r & 3) + 8 * (r >> 2) + 4 * hi; }

template <int DQK> struct Cfg {
    static constexpr float SCALE = DQK == 192 ? 0.07216878364870323f : 0.08838834764831845f;
    static constexpr int KROW = DQK * 2;
    static constexpr size_t SHM_V = KVBLK * 128 * 2, SHM_K = (size_t)KVBLK * DQK * 2;
    static constexpr size_t SHM_TOTAL = 2 * SHM_V + 2 * SHM_K + NW * 64 * 4;
};
template <int DQK> __device__ __forceinline__ int kswz(int row, int colB) {
    if constexpr (DQK == 128) return row * 256 + (colB ^ ((row & 15) << 4));
    else return row * (DQK * 2) + (colB ^ (((row >> 1) & 7) << 4));
}

constexpr float THRL = THR * 1.4426950408889634f;
template <int MODE>
__device__ __forceinline__ void partialSM(f32x16& p0, f32x16& p1, float& m_reg, float& alpha) {
    constexpr bool FIRST = MODE == 1;
    if constexpr (MODE == 2) { alpha = 1.f;
#pragma unroll
        for (int r = 0; r < 16; ++r) p0[r] = __builtin_amdgcn_exp2f(p0[r]);
        return; }
    float pmax = p0[0];
#pragma unroll
    for (int r = 1; r < 16; ++r) pmax = fmaxf(pmax, p0[r]);
#pragma unroll
    for (int r = 0; r < 16; ++r) pmax = fmaxf(pmax, p1[r]);
    { auto rr = __builtin_amdgcn_permlane32_swap(__float_as_uint(pmax), __float_as_uint(pmax), false, false);
      pmax = fmaxf(__uint_as_float(rr[0]), __uint_as_float(rr[1])); }
    if constexpr (FIRST) {
        m_reg = pmax; alpha = 1.f;
#pragma unroll
        for (int r = 0; r < 16; ++r) { p0[r] -= pmax; p1[r] -= pmax; }
    } else {
        if (__builtin_expect(__all(pmax <= THRL), 1)) { alpha = 1.f; }
        else { const float d = fmaxf(pmax, 0.f); alpha = __builtin_amdgcn_exp2f(-d); m_reg += d;
#pragma unroll
            for (int r = 0; r < 16; ++r) { p0[r] -= d; p1[r] -= d; } }
    }
#pragma unroll
    for (int r = 0; r < 16; ++r) p0[r] = __builtin_amdgcn_exp2f(p0[r]);
}
__device__ __forceinline__ void finishSM(f32x16& p0, f32x16& p1, float alpha, float& l_reg, bf16x8& pa0, bf16x8& pa1, bf16x8& pa2, bf16x8& pa3) {
#pragma unroll
    for (int r = 0; r < 16; ++r) p1[r] = __builtin_amdgcn_exp2f(p1[r]);
    float ps = 0;
#pragma unroll
    for (int r = 0; r < 16; ++r) ps += p0[r];
#pragma unroll
    for (int r = 0; r < 16; ++r) ps += p1[r];
    { auto rr = __builtin_amdgcn_permlane32_swap(__float_as_uint(ps), __float_as_uint(ps), false, false);
      ps = __uint_as_float(rr[0]) + __uint_as_float(rr[1]); }
    l_reg = l_reg * alpha + ps;
#define PK4(P, BASE, OUT) do { u32x4 w = {cvt_pk_bf16(P[BASE + 0], P[BASE + 1]), cvt_pk_bf16(P[BASE + 2], P[BASE + 3]), cvt_pk_bf16(P[BASE + 4], P[BASE + 5]), cvt_pk_bf16(P[BASE + 6], P[BASE + 7])}; \
    OUT = *reinterpret_cast<bf16x8*>(&w); } while (0)
    PK4(p0, 0, pa0); PK4(p0, 8, pa1); PK4(p1, 0, pa2); PK4(p1, 8, pa3);
#undef PK4
}
template <int DQK, bool ZINIT, bool QREG = false>
__device__ __forceinline__ void qkt(f32x16& p0, f32x16& p1, const char* Ks, const bf16x8* qr, const char* qrl, int r32, int hi, float negm) {
    if constexpr (!ZINIT) {
#pragma unroll
        for (int r = 0; r < 16; ++r) { p0[r] = negm; p1[r] = negm; } }
#pragma unroll
    for (int d0 = 0; d0 < 8; ++d0) { const int cb = (d0 * 16 + hi * 8) * 2;
        bf16x8 b0 = *reinterpret_cast<const bf16x8*>(Ks + kswz<DQK>(r32, cb));
        bf16x8 b1 = *reinterpret_cast<const bf16x8*>(Ks + kswz<DQK>(32 + r32, cb));
        if (ZINIT && d0 == 0) { p0 = __builtin_amdgcn_mfma_f32_32x32x16_bf16(b0, qr[d0], f32x16{}, 0, 0, 0);
                                p1 = __builtin_amdgcn_mfma_f32_32x32x16_bf16(b1, qr[d0], f32x16{}, 0, 0, 0); }
        else { p0 = __builtin_amdgcn_mfma_f32_32x32x16_bf16(b0, qr[d0], p0, 0, 0, 0);
               p1 = __builtin_amdgcn_mfma_f32_32x32x16_bf16(b1, qr[d0], p1, 0, 0, 0); }
    }
    if constexpr (DQK == 192) {
#pragma unroll
        for (int d0 = 8; d0 < 12; ++d0) { const int cb = (d0 * 16 + hi * 8) * 2;
            bf16x8 b0 = *reinterpret_cast<const bf16x8*>(Ks + kswz<DQK>(r32, cb));
            bf16x8 b1 = *reinterpret_cast<const bf16x8*>(Ks + kswz<DQK>(32 + r32, cb));
            bf16x8 q; if constexpr (QREG) q = qr[d0]; else q = *reinterpret_cast<const bf16x8*>(qrl + (d0 - 8) * 1024);
            p0 = __builtin_amdgcn_mfma_f32_32x32x16_bf16(b0, q, p0, 0, 0, 0);
            p1 = __builtin_amdgcn_mfma_f32_32x32x16_bf16(b1, q, p1, 0, 0, 0); }
    }
}
__device__ __forceinline__ int v_st(int k, int c) { const int kk = k; return ((kk >> 3) * 4 + (c >> 5)) * 512 + ((kk & 7) * 32 + (c & 31)) * 2; }
__device__ __forceinline__ int v_rd_base(int lane) { return ((lane & 3) << 3) | (((lane >> 2) & 3) << 6) | (((lane >> 4) & 1) << 5) | (((lane >> 5) & 1) << 8); }
constexpr int v_rd_off(int d0, int ks, int half) { return d0 * 512 + ks * 4096 + half * 2048; }
template <int OFF> __device__ __forceinline__ s16x4 tr_read(int vb) {
    s16x4 r; asm volatile("ds_read_b64_tr_b16 %0, %1 offset:%2" : "=&v"(r) : "v"(vb), "i"(OFF) : "memory"); return r;
}
template <int D0> __device__ __forceinline__ void pv_one(f32x16& od, int vb, bf16x8 pa0, bf16x8 pa1, bf16x8 pa2, bf16x8 pa3) {
    const s16x4 l0 = tr_read<v_rd_off(D0, 0, 0)>(vb), h0 = tr_read<v_rd_off(D0, 0, 1)>(vb), l1 = tr_read<v_rd_off(D0, 1, 0)>(vb), h1 = tr_read<v_rd_off(D0, 1, 1)>(vb);
    const s16x4 l2 = tr_read<v_rd_off(D0, 2, 0)>(vb), h2 = tr_read<v_rd_off(D0, 2, 1)>(vb), l3 = tr_read<v_rd_off(D0, 3, 0)>(vb), h3 = tr_read<v_rd_off(D0, 3, 1)>(vb);
    asm volatile("s_waitcnt lgkmcnt(0)" ::: "memory"); SBAR();
#define PK(L, H) (bf16x8){L[0], L[1], L[2], L[3], H[0], H[1], H[2], H[3]}
    od = __builtin_amdgcn_mfma_f32_32x32x16_bf16(pa0, PK(l0, h0), od, 0, 0, 0);
    od = __builtin_amdgcn_mfma_f32_32x32x16_bf16(pa1, PK(l1, h1), od, 0, 0, 0);
    od = __builtin_amdgcn_mfma_f32_32x32x16_bf16(pa2, PK(l2, h2), od, 0, 0, 0);
    od = __builtin_amdgcn_mfma_f32_32x32x16_bf16(pa3, PK(l3, h3), od, 0, 0, 0);
#undef PK
}
__device__ __forceinline__ void pv_d0(f32x16* o, int vb, bf16x8 pa0, bf16x8 pa1, bf16x8 pa2, bf16x8 pa3) {
    pv_one<0>(o[0], vb, pa0, pa1, pa2, pa3); pv_one<1>(o[1], vb, pa0, pa1, pa2, pa3); pv_one<2>(o[2], vb, pa0, pa1, pa2, pa3); pv_one<3>(o[3], vb, pa0, pa1, pa2, pa3);
}

template <int LDO>
__device__ __forceinline__ void epilogue(const f32x16 (&o)[4], bf16_t* __restrict__ Ob, char* wsbase) {
    int tid_ = threadIdx.x; asm volatile("" : "+v"(tid_));
    const int wid = tid_ >> 6, lane = tid_ & 63, r32 = lane & 31, hi = lane >> 5;
    const float* li_l = (const float*)wsbase + wid * 64;
    float rli[16];
#pragma unroll
    for (int r = 0; r < 16; ++r) rli[r] = __builtin_amdgcn_rcpf(li_l[crow(r, hi)]);
    GAS bf16_t* Ow = (GAS bf16_t*)Ob + (long)(wid * QBLK) * LDO;
#pragma unroll
    for (int r = 0; r < 16; ++r) { const int orow = crow(r, hi);
#pragma unroll
        for (int d0 = 0; d0 < 4; ++d0) Ow[(long)orow * LDO + d0 * 32 + r32] = f2bf(o[d0][r] * rli[r]); }
}
template <int DQK, int LDQ, int LDK, int LDV, int LDO, int SDEPTH, bool NOMAX = false>
__device__ __forceinline__ void attn_body(const bf16_t* __restrict__ Qb_, const bf16_t* __restrict__ Kh_, const bf16_t* __restrict__ Krh_, const bf16_t* __restrict__ Vh_,
                                          bf16_t* __restrict__ Ob, int seq, int qpos0, char* lds) {
    using C = Cfg<DQK>;
    const GAS bf16_t* Qb = (const GAS bf16_t*)Qb_; const GAS bf16_t* Kh = (const GAS bf16_t*)Kh_; const GAS bf16_t* Krh = (const GAS bf16_t*)Krh_; const GAS bf16_t* Vh = (const GAS bf16_t*)Vh_;
    constexpr size_t SHM_V = C::SHM_V, SHM_K = C::SHM_K;
    constexpr bool HASR = DQK == 192;
    constexpr bool QREG = HASR && NOMAX;
    int tid_ = threadIdx.x; asm volatile("" : "+v"(tid_));
    const int tid = tid_, wid = tid >> 6, lane = tid & 63, r32 = lane & 31, hi = lane >> 5;
    char* V_lds = lds; char* K_lds = lds + 2 * SHM_V;
    float* ws = (float*)(lds + 2 * SHM_V + 2 * SHM_K) + wid * 64; float* li_l = ws; float* al_l = ws + 32;
    float m_reg = 0.f, l_reg = 0; f32x16 o[4] = {}; bf16x8 qr[QREG ? 12 : 8];
    const GAS bf16_t* Qw = Qb + (long)(wid * QBLK + r32) * LDQ + hi * 8;
    constexpr float QC = C::SCALE * 1.4426950408889634f;
#pragma unroll
    for (int d0 = 0; d0 < 8; ++d0) { const bf16x8 q = *(const GAS bf16x8*)(Qw + d0 * 16);
        u32x4 w; w.x = cvt_pk_bf16(bf2f((bf16_t)q[0]) * QC, bf2f((bf16_t)q[1]) * QC); w.y = cvt_pk_bf16(bf2f((bf16_t)q[2]) * QC, bf2f((bf16_t)q[3]) * QC);
        w.z = cvt_pk_bf16(bf2f((bf16_t)q[4]) * QC, bf2f((bf16_t)q[5]) * QC); w.w = cvt_pk_bf16(bf2f((bf16_t)q[6]) * QC, bf2f((bf16_t)q[7]) * QC);
        qr[d0] = *reinterpret_cast<bf16x8*>(&w); }
    char* qrl = lds + 2 * SHM_V + 2 * SHM_K + NW * 64 * 4 + (wid * 4 * 64 + lane) * 16;
    if constexpr (HASR) {
        const int s = qpos0 + wid * QBLK + r32; const float prow = (float)(s >> 6), pcol = (float)(s & 63);
        const bf16x8 q8 = *(const GAS bf16x8*)(Qw + 128), q9 = *(const GAS bf16x8*)(Qw + 144),
                     q10 = *(const GAS bf16x8*)(Qw + 160), q11 = *(const GAS bf16x8*)(Qw + 176);
        float a1[8], a2[8], b1[8], b2[8];
#pragma unroll
        for (int e = 0; e < 8; ++e) { const float f = __builtin_amdgcn_exp2f(-(float)(hi * 8 + e) * (LOG2_THETA / 16.f));
            float sn, cs; sincos_hw(prow * f, sn, cs);
            float x1 = bf2f((bf16_t)q8[e]) * QC, x2 = bf2f((bf16_t)q9[e]) * QC; a1[e] = x1 * cs - x2 * sn; a2[e] = x2 * cs + x1 * sn;
            sincos_hw(pcol * f, sn, cs);
            x1 = bf2f((bf16_t)q10[e]) * QC; x2 = bf2f((bf16_t)q11[e]) * QC; b1[e] = x1 * cs - x2 * sn; b2[e] = x2 * cs + x1 * sn; }
        const u32x4 w0 = (u32x4){cvt_pk_bf16(a1[0], a1[1]), cvt_pk_bf16(a1[2], a1[3]), cvt_pk_bf16(a1[4], a1[5]), cvt_pk_bf16(a1[6], a1[7])};
        const u32x4 w1 = (u32x4){cvt_pk_bf16(a2[0], a2[1]), cvt_pk_bf16(a2[2], a2[3]), cvt_pk_bf16(a2[4], a2[5]), cvt_pk_bf16(a2[6], a2[7])};
        const u32x4 w2 = (u32x4){cvt_pk_bf16(b1[0], b1[1]), cvt_pk_bf16(b1[2], b1[3]), cvt_pk_bf16(b1[4], b1[5]), cvt_pk_bf16(b1[6], b1[7])};
        const u32x4 w3 = (u32x4){cvt_pk_bf16(b2[0], b2[1]), cvt_pk_bf16(b2[2], b2[3]), cvt_pk_bf16(b2[4], b2[5]), cvt_pk_bf16(b2[6], b2[7])};
        if constexpr (QREG) { qr[QREG ? 8 : 0] = *reinterpret_cast<const bf16x8*>(&w0); qr[QREG ? 9 : 0] = *reinterpret_cast<const bf16x8*>(&w1);
                              qr[QREG ? 10 : 0] = *reinterpret_cast<const bf16x8*>(&w2); qr[QREG ? 11 : 0] = *reinterpret_cast<const bf16x8*>(&w3); }
        else { *(u32x4*)(qrl) = w0; *(u32x4*)(qrl + 1024) = w1; *(u32x4*)(qrl + 2048) = w2; *(u32x4*)(qrl + 3072) = w3; }
    }
    const int sr = tid >> 4, sc = (tid & 15) * 8, vst0 = v_st(sr, sc), vst1 = v_st(32 + sr, sc);
    const int rr_ = tid >> 3, rc_ = (tid & 7) * 8;
    const int vb0 = (int)(uintptr_t)V_lds + v_rd_base(lane);
    struct { bf16x8 vs0, vs1, ks0, ks1, kr; } sr_[SDEPTH];
#define SLOAD(i, k0) do { sr_[i].vs0 = *(const GAS bf16x8*)(&Vh[(long)((k0) + sr) * LDV + sc]); sr_[i].vs1 = *(const GAS bf16x8*)(&Vh[(long)((k0) + 32 + sr) * LDV + sc]); \
    sr_[i].ks0 = *(const GAS bf16x8*)(&Kh[(long)((k0) + sr) * LDK + sc]); sr_[i].ks1 = *(const GAS bf16x8*)(&Kh[(long)((k0) + 32 + sr) * LDK + sc]); \
    if constexpr (HASR) sr_[i].kr = *(const GAS bf16x8*)(&Krh[(long)((k0) + rr_) * 64 + rc_]); } while (0)
#define SWRITE(b, i) do { *(bf16x8*)(V_lds + (b) * SHM_V + vst0) = sr_[i].vs0;          \
    *(bf16x8*)(V_lds + (b) * SHM_V + vst1) = sr_[i].vs1; const int kc = sc * 2;               \
    *(bf16x8*)(K_lds + (b) * SHM_K + kswz<DQK>(sr, kc)) = sr_[i].ks0;                       \
    *(bf16x8*)(K_lds + (b) * SHM_K + kswz<DQK>(32 + sr, kc)) = sr_[i].ks1;                  \
    if constexpr (HASR) *(bf16x8*)(K_lds + (b) * SHM_K + kswz<DQK>(rr_, 256 + rc_ * 2)) = sr_[i].kr; } while (0)
#define SWAIT() do { if constexpr (SDEPTH == 2) { if constexpr (HASR) asm volatile("s_waitcnt vmcnt(5)" ::: "memory"); else asm volatile("s_waitcnt vmcnt(4)" ::: "memory"); } \
    else asm volatile("s_waitcnt vmcnt(0)" ::: "memory"); } while (0)
#define RESC(a) do { if constexpr (!NOMAX) if (__any((a) < 1.f)) { if (hi == 0) al_l[r32] = (a); asm volatile("s_waitcnt lgkmcnt(0)" ::: "memory"); \
    _Pragma("unroll") for (int d = 0; d < 4; ++d) _Pragma("unroll") for (int r = 0; r < 16; ++r) o[d][r] *= al_l[crow(r, hi)]; } } while (0)
    f32x16 pA0, pA1, pB0, pB1; float alA, alB; bf16x8 pa0, pa1, pa2, pa3; const int NT = seq / KVBLK;
    constexpr int SE = 0, SO = SDEPTH - 1;
    SLOAD(SE, 0); asm volatile("s_waitcnt vmcnt(0)" ::: "memory"); SWRITE(0, SE); __syncthreads();
    qkt<DQK, NOMAX, QREG>(pA0, pA1, K_lds, qr, qrl, r32, hi, 0.f); partialSM<NOMAX ? 2 : 1>(pA0, pA1, m_reg, alA);
    SLOAD(SO, KVBLK); if constexpr (SDEPTH == 2) { if (2 < NT) SLOAD(SE, 2 * KVBLK); }
    SWAIT(); SWRITE(1, SO); __syncthreads();
    for (int j = 1; j + 1 < NT; j += 2) {
        SBAR(); qkt<DQK, NOMAX, QREG>(pB0, pB1, K_lds + SHM_K, qr, qrl, r32, hi, -m_reg);
        finishSM(pA0, pA1, alA, l_reg, pa0, pa1, pa2, pa3); SBAR();
        SLOAD(SO, (j + SDEPTH) * KVBLK); SBAR();
        pv_d0(o, vb0, pa0, pa1, pa2, pa3); partialSM<NOMAX ? 2 : 0>(pB0, pB1, m_reg, alB);
        __syncthreads(); SWAIT(); SWRITE(0, SE);
        RESC(alB); __syncthreads();
        SBAR(); qkt<DQK, NOMAX, QREG>(pA0, pA1, K_lds, qr, qrl, r32, hi, -m_reg);
        finishSM(pB0, pB1, alB, l_reg, pa0, pa1, pa2, pa3); SBAR();
        if (SDEPTH == 1 || j + 3 < NT) SLOAD(SE, (j + 1 + SDEPTH) * KVBLK); SBAR();
        pv_d0(o, vb0 + (int)SHM_V, pa0, pa1, pa2, pa3); partialSM<NOMAX ? 2 : 0>(pA0, pA1, m_reg, alA);
        __syncthreads(); SWAIT(); SWRITE(1, SO);
        RESC(alA); __syncthreads();
    }
    SBAR(); qkt<DQK, NOMAX, QREG>(pB0, pB1, K_lds + SHM_K, qr, qrl, r32, hi, -m_reg);
    finishSM(pA0, pA1, alA, l_reg, pa0, pa1, pa2, pa3); SBAR();
    pv_d0(o, vb0, pa0, pa1, pa2, pa3); partialSM<NOMAX ? 2 : 0>(pB0, pB1, m_reg, alB);
    __syncthreads(); RESC(alB);
    finishSM(pB0, pB1, alB, l_reg, pa0, pa1, pa2, pa3); SBAR();
    pv_d0(o, vb0 + (int)SHM_V, pa0, pa1, pa2, pa3);
    if (hi == 0) li_l[r32] = l_reg; asm volatile("s_waitcnt lgkmcnt(0)" ::: "memory");
    epilogue<LDO>(o, Ob, lds + 2 * SHM_V + 2 * SHM_K);
    asm volatile("s_waitcnt vmcnt(0)" ::: "memory");
    __syncthreads();
#undef SLOAD
#undef SWRITE
#undef SWAIT
#undef RESC
}
#if 0
    float rli[16];
#pragma unroll
    for (int r = 0; r < 16; ++r) rli[r] = __builtin_amdgcn_rcpf(li_l[crow(r, hi)]);
    bf16_t* Ow = Ob + (long)(wid * QBLK) * LDO;
#pragma unroll
    for (int r = 0; r < 16; ++r) { const int orow = crow(r, hi);
#pragma unroll
        for (int d0 = 0; d0 < 4; ++d0) Ow[(long)orow * LDO + d0 * 32 + r32] = f2bf(o[d0][r] * rli[r]); }
    asm volatile("s_waitcnt vmcnt(0)" ::: "memory");
    __syncthreads();
#endif
}

#define XB_TMO      128
#define XB_XCNT(j)  (256  + 64 * (j))
#define XB_XSUB(j)  (1280 + 64 * (j))
#define XB_XGEN(j)  (2304 + 64 * (j))
#define XB_TOP      3328
#define XB_TOPGEN   3392
#define XCD_BAR_WORDS 3456
#define XB_SPIN_CAP (1u << 22)
__device__ __forceinline__ unsigned xb_ld(unsigned* p)              { return __hip_atomic_load(p, __ATOMIC_RELAXED, __HIP_MEMORY_SCOPE_AGENT); }
__device__ __forceinline__ unsigned xb_add(unsigned* p, unsigned v) { return __hip_atomic_fetch_add(p, v, __ATOMIC_RELAXED, __HIP_MEMORY_SCOPE_AGENT); }
__device__ __forceinline__ unsigned xb_xcc_id() { return (unsigned)__builtin_amdgcn_s_getreg((3 << 11) | 20) & 0xFu; }
#define XB_SPIN(cond, bar) do { unsigned _sp = 0; while (cond) { __builtin_amdgcn_s_sleep(1); \
    if ((++_sp & 255u) == 0u) { if (xb_ld(&(bar)[XB_TMO])) break; if (_sp > XB_SPIN_CAP) { atomicAdd(&(bar)[XB_TMO], 1u); break; } } } } while (0)
struct XcdBarrier { unsigned* bar; unsigned x; volatile LAS unsigned* st; };
__device__ __forceinline__ XcdBarrier xcd_barrier_post(unsigned* bar, volatile LAS unsigned* st) {
    XcdBarrier b; b.bar = bar; b.x = xb_xcc_id(); b.st = st;
    if (threadIdx.x == 0) (void)xb_add(&bar[XB_XCNT(b.x)], 1u);
    return b;
}
__device__ __forceinline__ void xcd_barrier_complete(unsigned* bar, unsigned x, unsigned& nloc, unsigned& nx) {
    const unsigned G = gridDim.x * gridDim.y * gridDim.z;
    unsigned sum, cnt, mine, sp = 0u;
    for (;;) {
        sum = 0u; cnt = 0u; mine = 0u;
#pragma unroll
        for (unsigned j = 0; j < 16; ++j) { const unsigned c = xb_ld(&bar[XB_XCNT(j)]); sum += c; cnt += (c > 0u) ? 1u : 0u; mine = (j == x) ? c : mine; }
        if (sum == G) break;
        __builtin_amdgcn_s_sleep(1);
        if ((++sp & 255u) == 0u) { if (xb_ld(&bar[XB_TMO])) break; if (sp > XB_SPIN_CAP) { atomicAdd(&bar[XB_TMO], 1u); break; } }
    }
    nloc = mine > 0u ? mine : 1u; nx = cnt > 0u ? cnt : 1u;
}
__device__ __forceinline__ void xcd_barrier(const XcdBarrier& b) {
    asm volatile("s_waitcnt vmcnt(0)" ::: "memory");
    __syncthreads();
    if (threadIdx.x == 0) {
        unsigned* bar = b.bar; asm volatile("" : "+s"(bar));
        __builtin_amdgcn_s_waitcnt(0);
        unsigned nloc = b.st[0], nx = b.st[1];
        if (nloc == 0u) { xcd_barrier_complete(bar, b.x, nloc, nx); b.st[0] = nloc; b.st[1] = nx; }
        const unsigned old = xb_add(&bar[XB_XSUB(b.x)], 1u);
        const unsigned gen = old / nloc;
        if (old + 1u == (gen + 1u) * nloc) {
            __builtin_amdgcn_fence(__ATOMIC_RELEASE, "agent");
            asm volatile("s_waitcnt vmcnt(0)" ::: "memory");
            const unsigned og = xb_add(&bar[XB_TOP], 1u);
            const unsigned tg = og / nx;
            if (og + 1u == (tg + 1u) * nx) xb_add(&bar[XB_TOPGEN], 1u);
            else XB_SPIN(xb_ld(&bar[XB_TOPGEN]) == tg, bar);
            __builtin_amdgcn_fence(__ATOMIC_ACQUIRE, "agent");
            xb_add(&bar[XB_XGEN(b.x)], 1u);
            asm volatile("s_waitcnt vmcnt(0)" ::: "memory");
        } else {
            XB_SPIN(xb_ld(&bar[XB_XGEN(b.x)]) == gen, bar);
            __builtin_amdgcn_fence(__ATOMIC_ACQUIRE, "agent");
            asm volatile("s_waitcnt vmcnt(0)" ::: "memory");
        }
    }
    __syncthreads();
}

struct Params {
    const float* in[15];
    float* out;
    unsigned char* ws;
    int ph_lo, ph_hi;
};

__device__ __forceinline__ void transpose_item(const float* W, int K, int N, bf16_t* WT, LAS float* scr, int item, int lane, const float* gain = nullptr) {
    const int nblk = N / 32, kb = item / nblk, nb = item % nblk, k0 = 64 * kb, n0 = 32 * nb;
#pragma unroll 8
    for (int i = 0; i < 32; ++i) { const int kk = 2 * i + (lane >> 5); scr[kk * 33 + (lane & 31)] = W[(size_t)(k0 + kk) * N + n0 + (lane & 31)]; }
    asm volatile("s_waitcnt lgkmcnt(0)" ::: "memory");
    const int c = lane & 7;
    f32x4 g0 = {1.f, 1.f, 1.f, 1.f}, g1 = g0;
    if (gain) { g0 = *(const f32x4*)(gain + k0 + 8 * c); g1 = *(const f32x4*)(gain + k0 + 8 * c + 4); }
#pragma unroll
    for (int j = 0; j < 4; ++j) { const int n = (lane >> 3) + 8 * j; const LAS float* s = scr + (8 * c) * 33 + n;
        u32x4 o; o.x = cvt_pk_bf16(s[0 * 33] * g0[0], s[1 * 33] * g0[1]); o.y = cvt_pk_bf16(s[2 * 33] * g0[2], s[3 * 33] * g0[3]); o.z = cvt_pk_bf16(s[4 * 33] * g1[0], s[5 * 33] * g1[1]); o.w = cvt_pk_bf16(s[6 * 33] * g1[2], s[7 * 33] * g1[3]);
        *(u32x4*)(WT + (size_t)(n0 + n) * K + k0 + 8 * c) = o; }
    asm volatile("s_waitcnt lgkmcnt(0)" ::: "memory");
}

__device__ __forceinline__ void phase_weights(const Params& p, int layer, LAS unsigned char* lds, int gw, int NGW, int wave, int lane) {
    LAS float* scr = (LAS float*)(lds + wave * 8704);
    size_t wz_ = 0; asm volatile("" : "+s"(wz_)); unsigned char* ws = p.ws + wz_;
    const float* w_in = p.in[3] + (size_t)layer * DM * INW;
    const float* w_q = p.in[5] + (size_t)layer * QLORA * QA_W;
    const float* w_kv = p.in[7] + (size_t)layer * KVLORA * KVA_W;
    const float* w_o = p.in[10] + (size_t)layer * DM * DM;
    const float* w_up = p.in[12] + (size_t)layer * DM * DFF;
    const float* w_dn = p.in[13] + (size_t)layer * DFF * DM;
    constexpr int I_IN = (DM / 64) * (INW / 32), I_Q = (QLORA / 64) * (QA_W / 32), I_KV = (KVLORA / 64) * (KVA_W / 32), I_O = (DM / 64) * (DM / 32),
                  I_UP = (DM / 64) * (DFF / 32), I_DN = (DFF / 64) * (DM / 32), NITEMS = I_IN + I_Q + I_KV + I_O + I_UP + I_DN;
    for (int it = gw; it < NITEMS; it += NGW) {
        int r = it;
        if (r < I_IN) { transpose_item(w_in, DM, INW, (bf16_t*)(ws + W_IN), scr, r, lane, layer == 0 ? nullptr : p.in[2] + layer * DM); continue; } r -= I_IN;
        if (r < I_Q) { transpose_item(w_q, QLORA, QA_W, (bf16_t*)(ws + W_Q), scr, r, lane); continue; } r -= I_Q;
        if (r < I_KV) { transpose_item(w_kv, KVLORA, KVA_W, (bf16_t*)(ws + W_KV), scr, r, lane); continue; } r -= I_KV;
        if (r < I_O) { transpose_item(w_o, DM, DM, (bf16_t*)(ws + W_O), scr, r, lane); continue; } r -= I_O;
        if (r < I_UP) { transpose_item(w_up, DM, DFF, (bf16_t*)(ws + W_UP), scr, r, lane, p.in[11] + layer * DM); continue; } r -= I_UP;
        transpose_item(w_dn, DFF, DM, (bf16_t*)(ws + W_DN), scr, r, lane);
    }
    u32x4* pad = (u32x4*)(ws + W_IN + (size_t)INW * DM * 2);
    unsigned zz = 0u; asm volatile("" : "+v"(zz));
    for (int i = gw * 64 + lane; i < 64 * DM * 2 / 16; i += NGW * 64) pad[i] = (u32x4){zz, zz, zz, zz};
}

__device__ __forceinline__ void ld8f(const bf16_t* p, float (&v)[8]) {
    const u32x4 w = *(const u32x4*)p;
    v[0] = __uint_as_float(w.x << 16); v[1] = __uint_as_float(w.x & 0xffff0000u); v[2] = __uint_as_float(w.y << 16); v[3] = __uint_as_float(w.y & 0xffff0000u);
    v[4] = __uint_as_float(w.z << 16); v[5] = __uint_as_float(w.z & 0xffff0000u); v[6] = __uint_as_float(w.w << 16); v[7] = __uint_as_float(w.w & 0xffff0000u);
}
__device__ __forceinline__ void st8f(bf16_t* p, const float (&v)[8]) {
    u32x4 w; w.x = cvt_pk_bf16(v[0], v[1]); w.y = cvt_pk_bf16(v[2], v[3]); w.z = cvt_pk_bf16(v[4], v[5]); w.w = cvt_pk_bf16(v[6], v[7]); *(u32x4*)p = w;
}
__device__ __forceinline__ void rms_row_to_bf16(const float* xrow, const f32x4 (&g)[4], bf16_t* orow, int lane) {
    const f32x4* xr = (const f32x4*)xrow + lane;
    f32x4 v[4]; float s = 0.f;
#pragma unroll
    for (int j = 0; j < 4; ++j) { v[j] = xr[64 * j]; s += (v[j].x * v[j].x + v[j].y * v[j].y) + (v[j].z * v[j].z + v[j].w * v[j].w); }
    const float rstd = 1.f / sqrtf(wave_sum(s) * (1.f / DM) + EPS);
    u32x2* o8 = (u32x2*)orow + lane;
#pragma unroll
    for (int j = 0; j < 4; ++j) { u32x2 w; w.x = cvt_pk_bf16(v[j].x * rstd * g[j].x, v[j].y * rstd * g[j].y); w.y = cvt_pk_bf16(v[j].z * rstd * g[j].z, v[j].w * rstd * g[j].w); o8[64 * j] = w; }
}
__device__ __forceinline__ void phase_norm(const float* x_lo, const float* x_hi, const float* gain, bf16_t* H, int gw, int NGW, int lane) {
    f32x4 g[4];
#pragma unroll
    for (int j = 0; j < 4; ++j) g[j] = ((const f32x4*)gain)[lane + 64 * j];
    for (int m = gw; m < T; m += NGW) {
        const float* xr = m < T_PROMPT ? x_lo + (size_t)m * DM : x_hi + (size_t)(m - T_PROMPT) * DM;
        rms_row_to_bf16(xr, g, H + (size_t)m * DM, lane);
    }
}
__device__ __forceinline__ void phase_norm_b16(const bf16_t* Xb, const float* gain, bf16_t* H, int gw, int NGW, int lane) {
    f32x4 g[4];
#pragma unroll
    for (int j = 0; j < 2; ++j) { g[2 * j] = *(const f32x4*)(gain + 512 * j + 8 * lane); g[2 * j + 1] = *(const f32x4*)(gain + 512 * j + 8 * lane + 4); }
    for (int m = gw; m < T; m += NGW) {
        float v[2][8]; float s = 0.f;
#pragma unroll
        for (int j = 0; j < 2; ++j) { ld8f(Xb + (size_t)m * DM + 512 * j + 8 * lane, v[j]);
#pragma unroll
            for (int e = 0; e < 8; ++e) s += v[j][e] * v[j][e]; }
        const float rstd = 1.f / sqrtf(wave_sum(s) * (1.f / DM) + EPS);
#pragma unroll
        for (int j = 0; j < 2; ++j) {
#pragma unroll
            for (int e = 0; e < 8; ++e) v[j][e] *= rstd * g[2 * j + (e >> 2)][e & 3];
            st8f(H + (size_t)m * DM + 512 * j + 8 * lane, v[j]); }
    }
}
__device__ __forceinline__ void phase_rowstats(const bf16_t* Xb, float* RS, int gw, int NGW, int lane) {
    for (int m = gw; m < T; m += NGW) {
        float v[2][8]; float s = 0.f;
#pragma unroll
        for (int j = 0; j < 2; ++j) { ld8f(Xb + (size_t)m * DM + 512 * j + 8 * lane, v[j]);
#pragma unroll
            for (int e = 0; e < 8; ++e) s += v[j][e] * v[j][e]; }
        const float rstd = 1.f / sqrtf(wave_sum(s) * (1.f / DM) + EPS);
        if (lane == 0) RS[m] = rstd;
    }
}
__device__ __forceinline__ void phase_final_norm_b16(const bf16_t* Xb, float* out, const float* gain, int gw, int NGW, int lane) {
    f32x4 g[4];
#pragma unroll
    for (int j = 0; j < 2; ++j) { g[2 * j] = *(const f32x4*)(gain + 512 * j + 8 * lane); g[2 * j + 1] = *(const f32x4*)(gain + 512 * j + 8 * lane + 4); }
    for (int m = gw; m < T; m += NGW) {
        float v[2][8]; float s = 0.f;
#pragma unroll
        for (int j = 0; j < 2; ++j) { ld8f(Xb + (size_t)m * DM + 512 * j + 8 * lane, v[j]);
#pragma unroll
            for (int e = 0; e < 8; ++e) s += v[j][e] * v[j][e]; }
        const float rstd = 1.f / sqrtf(wave_sum(s) * (1.f / DM) + EPS);
#pragma unroll
        for (int j = 0; j < 2; ++j) { float* o = out + (size_t)m * DM + 512 * j + 8 * lane;
            *(f32x4*)o = (f32x4){v[j][0], v[j][1], v[j][2], v[j][3]} * rstd * g[2 * j];
            *(f32x4*)(o + 4) = (f32x4){v[j][4], v[j][5], v[j][6], v[j][7]} * rstd * g[2 * j + 1]; }
    }
}
__device__ __forceinline__ void phase_final_norm(float* X, const float* gain, int gw, int NGW, int lane) {
    f32x4 g[4];
#pragma unroll
    for (int j = 0; j < 4; ++j) g[j] = ((const f32x4*)gain)[lane + 64 * j];
    for (int m = gw; m < T; m += NGW) {
        f32x4* xr = (f32x4*)(X + (size_t)m * DM) + lane;
        f32x4 v[4]; float s = 0.f;
#pragma unroll
        for (int j = 0; j < 4; ++j) { v[j] = xr[64 * j]; s += (v[j].x * v[j].x + v[j].y * v[j].y) + (v[j].z * v[j].z + v[j].w * v[j].w); }
        const float rstd = 1.f / sqrtf(wave_sum(s) * (1.f / DM) + EPS);
#pragma unroll
        for (int j = 0; j < 4; ++j) xr[64 * j] = v[j] * rstd * g[j];
    }
}

__device__ __forceinline__ float sum8lanes(float v) { const int l = lane_opaque(); v += shx(v, 1, l); v += shx(v, 2, l); v += shx(v, 4, l); return v; }
__device__ __forceinline__ void head_norm_rope(const bf16_t* za, const float* g, bf16_t* out, int sl, const float (&sr)[8], const float (&cr)[8], const float (&sc)[8], const float (&cc)[8], float rs) {
    float a[8], b[8], ga[8], gb[8]; ld8f(za, a); ld8f(za + 64, b);
#pragma unroll
    for (int e = 0; e < 8; ++e) { a[e] *= rs; b[e] *= rs; }
    *(f32x4*)&ga[0] = *(const f32x4*)(g + 8 * sl); *(f32x4*)&ga[4] = *(const f32x4*)(g + 8 * sl + 4);
    *(f32x4*)&gb[0] = *(const f32x4*)(g + 64 + 8 * sl); *(f32x4*)&gb[4] = *(const f32x4*)(g + 64 + 8 * sl + 4);
    float ss = 0.f;
#pragma unroll
    for (int e = 0; e < 8; ++e) ss += a[e] * a[e] + b[e] * b[e];
    const float rstd = 1.f / sqrtf(sum8lanes(ss) * (1.f / HD) + EPS);
    const bool second = sl >= 4; const int ln = lane_opaque();
#pragma unroll
    for (int e = 0; e < 8; ++e) { const float xa = a[e] * rstd * ga[e], xb = b[e] * rstd * gb[e];
        const float ya = shx(xa, 4, ln), yb = shx(xb, 4, ln);
        a[e] = second ? (xa * cr[e] + ya * sr[e]) : (xa * cr[e] - ya * sr[e]);
        b[e] = second ? (xb * cc[e] + yb * sc[e]) : (xb * cc[e] - yb * sc[e]); }
    st8f(out, a); st8f(out + 64, b);
}
__device__ __forceinline__ void phase_post(const Params& p, int layer, int gw, int NGW, int lane) {
    size_t wz_ = 0; asm volatile("" : "+s"(wz_)); unsigned char* ws = p.ws + wz_;
    const bf16_t* Z = (const bf16_t*)(ws + A_Z);
    bf16_t* CQN = (bf16_t*)(ws + A_CQN); bf16_t* CKVN = (bf16_t*)(ws + A_CKVN); bf16_t* KR = (bf16_t*)(ws + A_KR);
    bf16_t* QB = (bf16_t*)(ws + A_QB); bf16_t* KB = (bf16_t*)(ws + A_KB); bf16_t* VB = (bf16_t*)(ws + A_VB);
    const float* gq = p.in[4] + layer * QLORA; const float* gkv = p.in[6] + layer * KVLORA;
    const float* gbq = p.in[8] + layer * HD; const float* gbk = p.in[9] + layer * HD;
    const int sl = lane & 7, tw = lane >> 3;
    float f64[8], f32_[8];
#pragma unroll
    for (int e = 0; e < 8; ++e) { f64[e] = __builtin_amdgcn_exp2f(-(float)(8 * (sl & 3) + e) * (LOG2_THETA / 32.f));
                                  f32_[e] = __builtin_amdgcn_exp2f(-(float)(8 * (sl & 1) + e) * (LOG2_THETA / 16.f)); }
    float krmax = 0.f;
    for (int grp = gw; grp < T / 8; grp += NGW) {
        const int tok = grp * 8 + tw;
        const bf16_t* z = Z + (size_t)tok * INW_PAD + 8 * sl;
        const int s = seq_pos(tok); const float prow = (float)(s >> 6), pcol = (float)(s & 63);
        float rs = 1.f;
        if (layer > 0) { const float* sp = (const float*)(ws + WS_RS2) + (size_t)tok * 16 + 2 * sl; rs = 1.f / sqrtf(sum8lanes(sp[0] + sp[1]) * (1.f / DM) + EPS); }
        { float v[6][8]; float ss = 0.f;
#pragma unroll
          for (int c = 0; c < 6; ++c) { ld8f(z + 64 * c, v[c]);
#pragma unroll
              for (int e = 0; e < 8; ++e) { v[c][e] *= rs; ss += v[c][e] * v[c][e]; } }
          const float rstd = 1.f / sqrtf(sum8lanes(ss) * (1.f / QLORA) + EPS);
#pragma unroll
          for (int c = 0; c < 6; ++c) { float g[8]; *(f32x4*)&g[0] = *(const f32x4*)(gq + 64 * c + 8 * sl); *(f32x4*)&g[4] = *(const f32x4*)(gq + 64 * c + 8 * sl + 4);
#pragma unroll
              for (int e = 0; e < 8; ++e) v[c][e] *= rstd * g[e];
              st8f(CQN + (size_t)tok * QLORA + 64 * c + 8 * sl, v[c]); } }
        { float v[4][8]; float ss = 0.f;
#pragma unroll
          for (int c = 0; c < 4; ++c) { ld8f(z + 64 * (6 + c), v[c]);
#pragma unroll
              for (int e = 0; e < 8; ++e) { v[c][e] *= rs; ss += v[c][e] * v[c][e]; } }
          const float rstd = 1.f / sqrtf(sum8lanes(ss) * (1.f / KVLORA) + EPS);
#pragma unroll
          for (int c = 0; c < 4; ++c) { float g[8]; *(f32x4*)&g[0] = *(const f32x4*)(gkv + 64 * c + 8 * sl); *(f32x4*)&g[4] = *(const f32x4*)(gkv + 64 * c + 8 * sl + 4);
#pragma unroll
              for (int e = 0; e < 8; ++e) v[c][e] *= rstd * g[e];
              st8f(CKVN + (size_t)tok * KVLORA + 64 * c + 8 * sl, v[c]); } }
        { float x[8]; ld8f(z + 640, x);
#pragma unroll
          for (int e = 0; e < 8; ++e) x[e] *= rs;
          const float pos = sl < 4 ? prow : pcol; const bool second = (sl & 2) != 0; const int lnk = lane_opaque();
#pragma unroll
          for (int e = 0; e < 8; ++e) { float sn, cs; sincos_hw(pos * f32_[e], sn, cs); const float y = shx(x[e], 2, lnk);
              x[e] = second ? (x[e] * cs + y * sn) : (x[e] * cs - y * sn); }
          st8f(KR + (size_t)tok * ROPE + 8 * sl, x);
          float ss = 0.f;
#pragma unroll
          for (int e = 0; e < 8; ++e) ss += x[e] * x[e];
          krmax = fmaxf(krmax, sum8lanes(ss)); }
        { float sr[8], cr[8], sc[8], cc[8];
#pragma unroll
          for (int e = 0; e < 8; ++e) { sincos_hw(prow * f64[e], sr[e], cr[e]); sincos_hw(pcol * f64[e], sc[e], cc[e]); }
#pragma unroll
          for (int h = 0; h < 4; ++h) head_norm_rope(z + 704 + 128 * h, gbq, QB + (size_t)tok * 512 + 128 * h + 8 * sl, sl, sr, cr, sc, cc, rs);
#pragma unroll
          for (int h = 0; h < 2; ++h) head_norm_rope(z + 1216 + 128 * h, gbk, KB + (size_t)tok * 256 + 128 * h + 8 * sl, sl, sr, cr, sc, cc, rs); }
        if (layer > 0) {
#pragma unroll
            for (int c = 0; c < 4; ++c) { float x[8]; ld8f(z + 1472 + 64 * c, x);
#pragma unroll
                for (int e = 0; e < 8; ++e) x[e] *= rs;
                st8f(VB + (size_t)tok * 256 + 64 * c + 8 * sl, x); } }
    }
    { const int ln = lane_opaque(); krmax = fmaxf(krmax, shx(krmax, 8, ln)); krmax = fmaxf(krmax, shx(krmax, 16, ln)); krmax = fmaxf(krmax, shx(krmax, 32, ln)); }
    if (lane == 0) atomicMax((unsigned*)(ws + WS_SLOTS) + 64 * layer + 40, __float_as_uint(krmax));
}

#ifndef ATT_SD_MLA
#define ATT_SD_MLA 1
#endif
#ifndef ATT_SD_GQA
#define ATT_SD_GQA 2
#endif
__device__ __forceinline__ void phase_attn(const Params& p, int layer, char* lds, int G, int bid) {
    size_t wz_ = 0; asm volatile("" : "+s"(wz_)); unsigned char* ws = p.ws + wz_;
    const bf16_t* QA = (const bf16_t*)(ws + A_QA); const bf16_t* KVA = (const bf16_t*)(ws + A_KVA); const bf16_t* KR = (const bf16_t*)(ws + A_KR);
    const bf16_t* QB = (const bf16_t*)(ws + A_QB); const bf16_t* KB = (const bf16_t*)(ws + A_KB); const bf16_t* VB = (const bf16_t*)(ws + A_VB);
    bf16_t* O = (bf16_t*)(ws + A_O);
    bool gqa_nomax;
    { int tid_ = threadIdx.x; asm volatile("" : "+v"(tid_)); const int lane = tid_ & 63; const float* gq = p.in[8] + layer * HD; const float* gk = p.in[9] + layer * HD;
      float mq = fmaxf(fabsf(gq[lane]), fabsf(gq[64 + lane])), mk = fmaxf(fabsf(gk[lane]), fabsf(gk[64 + lane]));
#pragma unroll
      for (int o = 1; o < 64; o <<= 1) { mq = fmaxf(mq, shx(mq, o, lane)); mk = fmaxf(mk, shx(mk, o, lane)); }
      const float bound = 16.33f * 1.02f * mq * mk;
      gqa_nomax = __builtin_amdgcn_readfirstlane((int)(bound < 40.f)) != 0; }
    unsigned mla_nomax = 0u;
    { const unsigned* sl_ = (const unsigned*)(ws + WS_SLOTS) + 64 * layer;
      const float kr = __uint_as_float(__hip_atomic_load(sl_ + 40, __ATOMIC_RELAXED, __HIP_MEMORY_SCOPE_AGENT));
#pragma unroll
      for (int h = 0; h < 4; ++h) { float sq = 0.f, sk = kr;
#pragma unroll
          for (int g = 0; g < 6; ++g) sq += __uint_as_float(__hip_atomic_load(sl_ + h * 6 + g, __ATOMIC_RELAXED, __HIP_MEMORY_SCOPE_AGENT));
#pragma unroll
          for (int g = 0; g < 4; ++g) sk += __uint_as_float(__hip_atomic_load(sl_ + 24 + h * 4 + g, __ATOMIC_RELAXED, __HIP_MEMORY_SCOPE_AGENT));
          const float bound = 0.07216878364870323f * 1.4426950408889634f * 1.03f * sqrtf(sq * sk);
          if (bound < 80.f) mla_nomax |= 1u << h; }
      mla_nomax = (unsigned)__builtin_amdgcn_readfirstlane((int)mla_nomax); }
    for (int v = bid; v < 256; v += G) {
        const int xcd = v & 7, slot = v >> 3;
        for (int it = 0; it < 6; ++it) {
            const bool prompt = it < 4; const bool mla = prompt ? (it < 2) : (it == 4);
            int b, h, qb, seq; size_t tok0;
            if (prompt) { b = xcd >> 2; h = xcd & 3; qb = 2 * slot + (it & 1); seq = S_PROMPT; tok0 = (size_t)b * S_PROMPT; }
            else { const int combo = 2 * xcd + (slot >> 4); b = combo >> 2; h = combo & 3; qb = slot & 15; seq = S_SAMPLE; tok0 = (size_t)T_PROMPT + (size_t)b * S_SAMPLE; }
            const size_t i0 = tok0 + (size_t)qb * 256;
#ifndef NO_MLA
            if (mla) { if ((mla_nomax >> h) & 1u) att::attn_body<192, QA_W, KVA_W, KVA_W, DM, ATT_SD_MLA, true>(QA + i0 * QA_W + h * 192, KVA + tok0 * KVA_W + h * 256, KR + tok0 * ROPE, KVA + tok0 * KVA_W + h * 256 + 128,
                                                                    O + i0 * DM + h * 128, seq, qb * 256, lds);
                       else att::attn_body<192, QA_W, KVA_W, KVA_W, DM, ATT_SD_MLA, false>(QA + i0 * QA_W + h * 192, KVA + tok0 * KVA_W + h * 256, KR + tok0 * ROPE, KVA + tok0 * KVA_W + h * 256 + 128,
                                                                    O + i0 * DM + h * 128, seq, qb * 256, lds); }
#endif
#ifndef NO_GQA
            if (!mla) { if (gqa_nomax) att::attn_body<128, 512, 256, 256, DM, ATT_SD_GQA, true>(QB + i0 * 512 + h * 128, KB + tok0 * 256 + (h >> 1) * 128, nullptr, VB + tok0 * 256 + (h >> 1) * 128,
                                                                O + i0 * DM + 512 + h * 128, seq, qb * 256, lds);
                        else att::attn_body<128, 512, 256, 256, DM, ATT_SD_GQA, false>(QB + i0 * 512 + h * 128, KB + tok0 * 256 + (h >> 1) * 128, nullptr, VB + tok0 * 256 + (h >> 1) * 128,
                                                                O + i0 * DM + 512 + h * 128, seq, qb * 256, lds); }
#endif
        }
    }
}

constexpr int PH_PER_LAYER = 9, N_PHASES = DEPTH * PH_PER_LAYER + 1;

__global__ void __launch_bounds__(NWAVES * 64, 2) hymba_fwd(Params p) {
    extern __shared__ __attribute__((aligned(16))) unsigned char lds_raw[];
    LAS unsigned char* lds = (LAS unsigned char*)lds_raw;
    const int G = gridDim.x, bid = blockIdx.x, NGW = G * NWAVES;
#define FRESH() int tid_ = threadIdx.x; asm volatile("" : "+v"(tid_)); const int lane = tid_ & 63, wave = __builtin_amdgcn_readfirstlane(tid_ >> 6), gw = bid * NWAVES + wave; (void)lane; (void)gw
    const int lo = p.ph_lo, hi = p.ph_hi;
#define WSP() size_t wz_ = 0; asm volatile("" : "+s"(wz_)); unsigned char* ws = p.ws + wz_
#if MK_PER_PHASE
#define GRID_SYNC() do {} while (0)
#else
    cg::grid_group grid = cg::this_grid();
    volatile LAS unsigned* xbst = (volatile LAS unsigned*)(lds + LDS_XB);
    if (threadIdx.x < 4) xbst[threadIdx.x] = 0u;
    __syncthreads();
    XcdBarrier xbar = xcd_barrier_post((unsigned*)(p.ws + WS_BAR), xbst);
    bool first_sync = true;
#define GRID_SYNC() do { if (first_sync) { grid.sync(); first_sync = false; } else xcd_barrier(xbar); } while (0)
#endif
#ifdef TESTPH
#define IN(k) ((k) == TESTPH)
#else
#define IN(k) (lo <= (k) && (k) < hi)
#endif
#define SEAM(k) do { if (IN((k) + 1)) GRID_SYNC(); } while (0)
    const float* x_prompt = p.in[0]; const float* x_sample = p.in[1];
    float* X = p.out;


#ifdef TESTPH
#pragma unroll
#endif
    for (int layer = 0; layer < DEPTH; ++layer) {
        const int pb = layer * PH_PER_LAYER;
        if (IN(pb + 0)) {
            FRESH(); WSP();
            for (int rep = 0; rep < REP_THIN; ++rep) {
#ifndef NO_WT
            phase_weights(p, layer, lds, gw, NGW, wave, lane);
#endif
            if (layer == 0) phase_norm(x_prompt, x_sample, p.in[2] + layer * DM, (bf16_t*)(ws + A_H), gw, NGW, lane);
            __syncthreads();
            }
            SEAM(pb + 0);
        }
        if (IN(pb + 1)) {
            WSP();
            pg8::Gemm g{layer == 0 ? (const bf16_t*)(ws + A_H) : (const bf16_t*)X, (const bf16_t*)(ws + W_IN), T, INW_PAD, DM}; pg8::StaticOrder S; S.init(T, INW_PAD, G, bid);
            pg8::EpiZ E{(bf16_t*)(ws + A_Z), (bf16_t*)(ws + A_VB), nullptr, layer == 0};
#ifndef NO_GEMM
            pg8::gemm_phase(lds, g, S, E);
#endif
            SEAM(pb + 1);
        }
        if (IN(pb + 2)) {
            FRESH();
#ifndef NO_POST
            for (int rep = 0; rep < REP_THIN; ++rep) phase_post(p, layer, gw, NGW, lane);
#endif
            SEAM(pb + 2); }
        if (IN(pb + 3)) {
            WSP();
            { pg8::Gemm g{(const bf16_t*)(ws + A_CQN), (const bf16_t*)(ws + W_Q), T, QA_W, QLORA}; pg8::StaticOrder S; S.init(T, QA_W, G, bid);
              pg8::EpiBf16Norm E{(bf16_t*)(ws + A_QA), QA_W, (unsigned*)(ws + WS_SLOTS) + 64 * layer, 0};
#ifndef NO_GEMM
              pg8::gemm_phase(lds, g, S, E);
#endif
            }
            { pg8::Gemm g{(const bf16_t*)(ws + A_CKVN), (const bf16_t*)(ws + W_KV), T, KVA_W, KVLORA}; pg8::StaticOrder S; S.init(T, KVA_W, G, bid);
              pg8::EpiBf16Norm E{(bf16_t*)(ws + A_KVA), KVA_W, (unsigned*)(ws + WS_SLOTS) + 64 * layer, 1};
#ifndef NO_GEMM
              pg8::gemm_phase(lds, g, S, E);
#endif
            }
            SEAM(pb + 3);
        }
        if (IN(pb + 4)) {
#ifndef NO_ATTN
            for (int rep = 0; rep < REP_ATTN; ++rep) phase_attn(p, layer, (char*)lds_raw, G, bid);
#endif
            SEAM(pb + 4); }
        if (IN(pb + 5)) {
            WSP();
            pg8::Gemm g{(const bf16_t*)(ws + A_O), (const bf16_t*)(ws + W_O), T, DM, DM}; pg8::StaticOrder S; S.init(T, DM, G, bid);
            if (layer == 0) { pg8::EpiResB16<true> E{(bf16_t*)X, x_prompt, x_sample, T_PROMPT, DM, nullptr, (float*)(ws + WS_RS)}; pg8::gemm_phase(lds, g, S, E); }
            else { pg8::EpiResB16<false> E{(bf16_t*)X, X, nullptr, 0, DM, nullptr, (float*)(ws + WS_RS)}; pg8::gemm_phase(lds, g, S, E); }
            SEAM(pb + 5);
        }
        if (IN(pb + 7)) {
            WSP();
            pg8::Gemm g{(const bf16_t*)X, (const bf16_t*)(ws + W_UP), T, DFF, DM}; pg8::StaticOrder S; S.init(T, DFF, G, bid);
            pg8::EpiBf16<1> E{(bf16_t*)(ws + A_U), DFF, nullptr};
#ifndef NO_GEMM
            pg8::gemm_phase(lds, g, S, E);
#endif
            SEAM(pb + 7);
        }
        if (IN(pb + 8)) {
            WSP();
            pg8::Gemm g{(const bf16_t*)(ws + A_U), (const bf16_t*)(ws + W_DN), T, DM, DFF}; pg8::StaticOrder S; S.init(T, DM, G, bid);
            pg8::EpiResB16<false> E{layer == DEPTH - 1 ? (bf16_t*)(ws + A_H2) : (bf16_t*)X, X, nullptr, 0, DM, (const float*)(ws + WS_RS), layer == DEPTH - 1 ? nullptr : (float*)(ws + WS_RS2)};
#ifndef NO_GEMM
            pg8::gemm_phase(lds, g, S, E);
#endif
            SEAM(pb + 8);
        }
    }
    if (IN(N_PHASES - 1)) { FRESH(); WSP(); phase_final_norm_b16((const bf16_t*)(ws + A_H2), X, p.in[14], gw, NGW, lane); }
#undef IN
#undef SEAM
#undef GRID_SYNC
}

extern "C" void kernel_launch(void* const* d_in, const int* in_sizes, int n_in, void* d_out, int out_size, void* d_ws, size_t ws_size, hipStream_t stream) {
    static int grid = 0;
    if (grid == 0) {
        if (n_in != 15 || out_size != T * DM || ws_size < WS_TOTAL) {
            fprintf(stderr, "kernel_launch: shape mismatch: n_in %d out %d ws %zu (need %zu)\n", n_in, out_size, ws_size, (size_t)WS_TOTAL); grid = -1; return; }
        int dev = 0, cus = 0, per_cu = 0;
        if (hipGetDevice(&dev) != hipSuccess || hipDeviceGetAttribute(&cus, hipDeviceAttributeMultiprocessorCount, dev) != hipSuccess) { fprintf(stderr, "kernel_launch: device query failed\n"); grid = -1; return; }
        if (hipFuncSetAttribute((const void*)hymba_fwd, hipFuncAttributeMaxDynamicSharedMemorySize, LDS_BYTES) != hipSuccess) { fprintf(stderr, "kernel_launch: hipFuncSetAttribute failed\n"); grid = -1; return; }
        if (hipOccupancyMaxActiveBlocksPerMultiprocessor(&per_cu, (const void*)hymba_fwd, NWAVES * 64, LDS_BYTES) != hipSuccess || per_cu < 1) {
            fprintf(stderr, "kernel_launch: occupancy query reports %d workgroups per CU\n", per_cu); per_cu = 1; }
        (void)hipGetLastError();
        grid = cus;
        if (grid > 256) grid = 256;
    }
    if (grid < 0) return;
    Params p{};
    for (int i = 0; i < 15; ++i) p.in[i] = (const float*)d_in[i];
    p.out = (float*)d_out; p.ws = (unsigned char*)d_ws;
#if !MK_PER_PHASE
    if (hipMemsetAsync((char*)d_ws + WS_BAR, 0, 16384, stream) != hipSuccess) { fprintf(stderr, "kernel_launch: memset of the barrier words failed\n"); return; }
#endif
#if MK_PER_PHASE
    for (int ph = 0; ph < N_PHASES; ++ph) {
        p.ph_lo = ph; p.ph_hi = ph + 1;
        hipLaunchKernelGGL(hymba_fwd, dim3(grid), dim3(NWAVES * 64), LDS_BYTES, stream, p);
    }
#else
    p.ph_lo = 0; p.ph_hi = N_PHASES;
    void* args[] = {&p};
    hipError_t e = hipLaunchCooperativeKernel((const void*)hymba_fwd, dim3(grid), dim3(NWAVES * 64), args, LDS_BYTES, stream);
    if (e != hipSuccess) fprintf(stderr, "kernel_launch: cooperative launch failed: %s (grid %d)\n", hipGetErrorString(e), grid);
#endif
}
```

```cpp
#include <hip/hip_runtime.h>
#include <hip/hip_cooperative_groups.h>
#include <cstdio>
#include <cstdint>
namespace cg = cooperative_groups;

#ifndef MK_PER_PHASE
#define MK_PER_PHASE 0
#endif

#ifndef REP_ATTN
#define REP_ATTN 1
#endif
#ifndef REP_THIN
#define REP_THIN 1
#endif
#define LAS __attribute__((address_space(3)))
#define GAS __attribute__((address_space(1)))
typedef unsigned short bf16_t;
typedef short bf16x8 __attribute__((ext_vector_type(8)));
typedef short s16x4 __attribute__((ext_vector_type(4)));
typedef float f32x4 __attribute__((ext_vector_type(4)));
typedef float f32x16 __attribute__((ext_vector_type(16)));
typedef unsigned u32x4 __attribute__((ext_vector_type(4)));
typedef unsigned u32x2 __attribute__((ext_vector_type(2)));

constexpr int DM = 1024, T_PROMPT = 2 * 16384, T_SAMPLE = 4 * 4096, T = T_PROMPT + T_SAMPLE;
constexpr int S_PROMPT = 16384, S_SAMPLE = 4096;
constexpr int DEPTH = 2;
constexpr int QLORA = 384, KVLORA = 256, NOPE = 128, ROPE = 64, VD = 128, HD = 128;
constexpr int INW = 1728, INW_PAD = 1792, DFF = 4096;
constexpr int QA_W = 4 * (NOPE + ROPE)  , KVA_W = 4 * (NOPE + VD)  ;
constexpr float EPS = 1e-6f;
constexpr float LOG2_THETA = 13.287712379549449f;
constexpr float INV_2PI = 0.15915494309189535f;

constexpr size_t W_IN = 0, W_Q = W_IN + (size_t)INW_PAD * DM * 2, W_KV = W_Q + (size_t)QA_W * QLORA * 2, W_O = W_KV + (size_t)KVA_W * KVLORA * 2,
                 W_UP = W_O + (size_t)DM * DM * 2, W_DN = W_UP + (size_t)DFF * DM * 2, W_END = W_DN + (size_t)DM * DFF * 2;
constexpr size_t AR = (W_END + 255) / 256 * 256;
constexpr size_t A_Z = AR, A_QA = A_Z, A_KVA = A_QA + (size_t)T * QA_W * 2;
constexpr size_t A_O = A_Z + (size_t)T * INW_PAD * 2, A_H = A_O;
constexpr size_t A_CQN = A_O + (size_t)T * DM * 2, A_CKVN = A_CQN + (size_t)T * QLORA * 2, A_KR = A_CKVN + (size_t)T * KVLORA * 2,
                 A_QB = A_KR + (size_t)T * ROPE * 2, A_KB = A_QB + (size_t)T * 512 * 2, A_VB = A_KB + (size_t)T * 256 * 2, A_END1 = A_VB + (size_t)T * 256 * 2;
constexpr size_t A_H2 = AR, A_U = A_H2 + (size_t)T * DM * 2, A_END2 = A_U + (size_t)T * DFF * 2;
constexpr size_t WS_NEED = A_END1 > A_END2 ? A_END1 : A_END2;
static_assert(A_KVA + (size_t)T * KVA_W * 2 == A_O, "QA|KVA must overlay Z exactly");

constexpr int LDS_XB = 131072;
constexpr int LDS_BYTES = 131072 + 16;
constexpr size_t WS_BAR = (WS_NEED + 255) / 256 * 256, WS_RS = WS_BAR + 16384, WS_TOTAL = WS_RS + (size_t)T * 16 * 4;
constexpr size_t WS_SLOTS = WS_BAR + 3456 * 4;
constexpr int NWAVES = 8;

__device__ __forceinline__ unsigned cvt_pk_bf16(float lo, float hi) { unsigned r; asm volatile("v_cvt_pk_bf16_f32 %0, %1, %2" : "=v"(r) : "v"(lo), "v"(hi)); return r; }
__device__ __forceinline__ bf16_t f2bf(float f) { unsigned u = __float_as_uint(f); u += 0x7FFFu + ((u >> 16) & 1u); return (bf16_t)(u >> 16); }
__device__ __forceinline__ float bf2f(bf16_t b) { return __uint_as_float(((unsigned)b) << 16); }
__device__ __forceinline__ int lane_opaque() { unsigned z = 0u; asm volatile("" : "+v"(z)); return (int)__builtin_amdgcn_mbcnt_hi(~0u, __builtin_amdgcn_mbcnt_lo(~0u, z)); }
__device__ __forceinline__ float shx(float v, int o, int l) { return __int_as_float(__builtin_amdgcn_ds_bpermute((l ^ o) << 2, __float_as_int(v))); }
__device__ __forceinline__ float wave_sum(float v) {
    const int l = lane_opaque();
#pragma unroll
    for (int o = 1; o < 64; o <<= 1) v += shx(v, o, l);
    return v;
}
__device__ __forceinline__ int seq_pos(int tok) { return tok < T_PROMPT ? (tok & (S_PROMPT - 1)) : (tok & (S_SAMPLE - 1)); }
__device__ __forceinline__ void sincos_hw(float ang, float& s, float& c) { const float r = ang * INV_2PI; s = __builtin_amdgcn_sinf(r); c = __builtin_amdgcn_cosf(r); }

namespace pg8 {
constexpr int BM = 256, BK = 64, HALF = 128, HTB = HALF * BK * 2, STAGE_BYTES = 8 * HTB, NXCD = 8, WGM = 8;
__host__ __device__ __forceinline__ int lds_byte(int r, int c) { const int st = (r >> 4) * 2 + (c >> 5), rr = r & 15, cc = c & 31, ob = rr * 64 + cc * 2; return st * 1024 + (ob ^ (((ob >> 9) & 1) << 5)); }
__host__ __device__ __forceinline__ void stage_rc(int b, int& R, int& C) { const int st = b / 1024, sb = b % 1024, swz = sb ^ (((sb >> 9) & 1) << 5); R = (st >> 1) * 16 + swz / 64; C = (st & 1) * 32 + (swz % 64) / 2; }
__host__ __device__ __forceinline__ int perm32(int rho) { const int n = rho >> 4, i = rho & 15; return 8 * (i >> 2) + 4 * n + (i & 3); }
struct Unit { int pm, pn; };
struct Gemm { const bf16_t* A; const bf16_t* Bt; int M, N, K; };
struct StaticOrder {
    int nM, nN, nwg, G, c;
    __device__ void init(int M, int N, int G_, int c_) { nM = M / BM; nN = N / BM; nwg = nM * nN; G = G_; c = c_; }
    __device__ bool next(int i, Unit& u) const {
        const long L = (long)i * G + c; if (L >= nwg) return false;
        int wgid = (int)L; { const int q = nwg / NXCD, r = nwg % NXCD, xcd = wgid % NXCD, off = wgid / NXCD; wgid = (xcd < r ? xcd * (q + 1) : r * (q + 1) + (xcd - r) * q) + off; }
        const int nig = WGM * nN, gid = wgid / nig, fm = gid * WGM, gsz = (nM - fm) < WGM ? (nM - fm) : WGM;
        u.pm = fm + ((wgid % nig) % gsz); u.pn = (wgid % nig) / gsz; return true;
    }
};
template <int ACT  > struct EpiBf16 {
    static constexpr bool PERM = true;
    bf16_t* O; int ldc; const float* rs;
    __device__ __forceinline__ void operator()(const f32x4 (&acc)[2][2][4][2], const Unit& u, int wr, int wc, int fr, int fq) const {
        const int row0 = u.pm * BM + wr * 64 + fr, col0 = u.pn * BM + wc * 32 + 8 * fq;
#pragma unroll
        for (int ai = 0; ai < 2; ++ai)
#pragma unroll
            for (int m = 0; m < 4; ++m) { bf16_t* rowp = O + (size_t)(row0 + ai * HALF + m * 16) * ldc + col0;
                const float sc = rs ? rs[row0 + ai * HALF + m * 16] : 1.f;
#pragma unroll
                for (int bj = 0; bj < 2; ++bj) { f32x4 v0 = acc[ai][bj][m][0] * sc, v1 = acc[ai][bj][m][1] * sc;
                    if (ACT == 1) {
#pragma unroll
                        for (int j = 0; j < 4; ++j) { const float a = fmaxf(v0[j], 0.f), b = fmaxf(v1[j], 0.f); v0[j] = a * a; v1[j] = b * b; } }
                    u32x4 w; w.x = cvt_pk_bf16(v0[0], v0[1]); w.y = cvt_pk_bf16(v0[2], v0[3]); w.z = cvt_pk_bf16(v1[0], v1[1]); w.w = cvt_pk_bf16(v1[2], v1[3]);
                    *(u32x4*)(rowp + bj * HALF) = w; } }
    }
};
struct EpiZ {
    static constexpr bool PERM = true;
    bf16_t* Z; bf16_t* VB; const float* rs;
    __device__ __forceinline__ void operator()(const f32x4 (&acc)[2][2][4][2], const Unit& u, int wr, int wc, int fr, int fq) const {
        const int row0 = u.pm * BM + wr * 64 + fr;
#pragma unroll
        for (int bj = 0; bj < 2; ++bj) {
            const int g0 = u.pn * BM + bj * HALF + wc * 32;
            const bool tovb = g0 >= 1472;
            bf16_t* base = tovb ? VB + (g0 - 1472) + 8 * fq : Z + g0 + 8 * fq; const int ld = tovb ? 256 : INW_PAD;
            if (g0 < INW) {
#pragma unroll
                for (int ai = 0; ai < 2; ++ai)
#pragma unroll
                    for (int m = 0; m < 4; ++m) { const float sc = rs ? rs[row0 + ai * HALF + m * 16] : 1.f; const f32x4 v0 = acc[ai][bj][m][0] * sc, v1 = acc[ai][bj][m][1] * sc;
                        u32x4 w; w.x = cvt_pk_bf16(v0[0], v0[1]); w.y = cvt_pk_bf16(v0[2], v0[3]); w.z = cvt_pk_bf16(v1[0], v1[1]); w.w = cvt_pk_bf16(v1[2], v1[3]);
                        *(u32x4*)(base + (size_t)(row0 + ai * HALF + m * 16) * ld) = w; } }
        }
    }
};
struct EpiBf16Norm {
    static constexpr bool PERM = true;
    bf16_t* O; int ldc; unsigned* slots; int mode;
    __device__ __forceinline__ void operator()(const f32x4 (&acc)[2][2][4][2], const Unit& u, int wr, int wc, int fr, int fq) const {
        const int row0 = u.pm * BM + wr * 64 + fr, col0 = u.pn * BM + wc * 32 + 8 * fq; const int ln = lane_opaque();
#pragma unroll
        for (int bj = 0; bj < 2; ++bj) {
            float mx = 0.f;
#pragma unroll
            for (int ai = 0; ai < 2; ++ai)
#pragma unroll
                for (int m = 0; m < 4; ++m) { const f32x4 v0 = acc[ai][bj][m][0], v1 = acc[ai][bj][m][1];
                    float ss = (v0[0] * v0[0] + v0[1] * v0[1]) + (v0[2] * v0[2] + v0[3] * v0[3]) + (v1[0] * v1[0] + v1[1] * v1[1]) + (v1[2] * v1[2] + v1[3] * v1[3]);
                    ss += shx(ss, 16, ln); ss += shx(ss, 32, ln); mx = fmaxf(mx, ss);
                    u32x4 w; w.x = cvt_pk_bf16(v0[0], v0[1]); w.y = cvt_pk_bf16(v0[2], v0[3]); w.z = cvt_pk_bf16(v1[0], v1[1]); w.w = cvt_pk_bf16(v1[2], v1[3]);
                    *(u32x4*)(O + (size_t)(row0 + ai * HALF + m * 16) * ldc + col0 + bj * HALF) = w; }
#pragma unroll
            for (int o = 1; o < 16; o <<= 1) mx = fmaxf(mx, shx(mx, o, ln));
            const int g0 = u.pn * BM + bj * HALF + wc * 32;
            const int slot = mode == 0 ? (g0 / 192) * 6 + (g0 % 192) / 32 : 24 + u.pn * 4 + wc;
            if (fr == 0 && fq == 0 && (mode == 0 || bj == 0)) atomicMax(slots + slot, __float_as_uint(mx));
        }
    }
};
template <bool RES_F32> struct EpiResB16 {
    static constexpr bool PERM = true;
    bf16_t* out; const void* res_lo; const void* res_hi; int split; int ldc;
    const float* st_in;
    float* st_out;
    __device__ __forceinline__ void operator()(const f32x4 (&acc)[2][2][4][2], const Unit& u, int wr, int wc, int fr, int fq) const {
        const int row0 = u.pm * BM + wr * 64 + fr, col0 = u.pn * BM + wc * 32 + 8 * fq;
#pragma unroll
        for (int ai = 0; ai < 2; ++ai)
#pragma unroll
            for (int m = 0; m < 4; ++m) { const int row = row0 + ai * HALF + m * 16; float sc = 1.f;
                if (st_in) { const f32x4* sp = (const f32x4*)(st_in + (size_t)row * 16); const f32x4 a = sp[0], b = sp[1], c = sp[2], d = sp[3];
                    const float ssum = ((a[0] + a[1]) + (a[2] + a[3])) + ((b[0] + b[1]) + (b[2] + b[3])) + ((c[0] + c[1]) + (c[2] + c[3])) + ((d[0] + d[1]) + (d[2] + d[3]));
                    sc = 1.f / (ssum * (1.f / 1024.f) + 1e-6f); }
                float ssq = 0.f;
#pragma unroll
                for (int bj = 0; bj < 2; ++bj) { f32x4 v0 = acc[ai][bj][m][0] * sc, v1 = acc[ai][bj][m][1] * sc;
                    if constexpr (RES_F32) { const float* rp = (row < split ? (const float*)res_lo + (size_t)row * ldc : (const float*)res_hi + (size_t)(row - split) * ldc) + col0 + bj * HALF;
                        v0 += *(const f32x4*)rp; v1 += *(const f32x4*)(rp + 4); }
                    else { const u32x4 r = *(const u32x4*)((const bf16_t*)res_lo + (size_t)row * ldc + col0 + bj * HALF);
                        v0[0] += __uint_as_float(r.x << 16); v0[1] += __uint_as_float(r.x & 0xffff0000u); v0[2] += __uint_as_float(r.y << 16); v0[3] += __uint_as_float(r.y & 0xffff0000u);
                        v1[0] += __uint_as_float(r.z << 16); v1[1] += __uint_as_float(r.z & 0xffff0000u); v1[2] += __uint_as_float(r.w << 16); v1[3] += __uint_as_float(r.w & 0xffff0000u); }
                    u32x4 w; w.x = cvt_pk_bf16(v0[0], v0[1]); w.y = cvt_pk_bf16(v0[2], v0[3]); w.z = cvt_pk_bf16(v1[0], v1[1]); w.w = cvt_pk_bf16(v1[2], v1[3]);
                    *(u32x4*)(out + (size_t)row * ldc + col0 + bj * HALF) = w;
                    ssq += ((v0[0] * v0[0] + v0[1] * v0[1]) + (v0[2] * v0[2] + v0[3] * v0[3])) + ((v1[0] * v1[0] + v1[1] * v1[1]) + (v1[2] * v1[2] + v1[3] * v1[3])); }
                if (st_out) { const int ln = lane_opaque(); ssq += shx(ssq, 16, ln); ssq += shx(ssq, 32, ln);
                    if (fq == 0) st_out[(size_t)row * 16 + u.pn * 4 + wc] = ssq; } }
    }
};
struct EpiResF32 {
    static constexpr bool PERM = false;
    float* C; const float* res_lo; const float* res_hi; int split; int ldc;
    __device__ __forceinline__ void operator()(const f32x4 (&acc)[2][2][4][2], const Unit& u, int wr, int wc, int fr, int fq) const {
        const int row0 = u.pm * BM + wr * 64 + fr, col0 = u.pn * BM + wc * 32 + 4 * fq;
#pragma unroll
        for (int ai = 0; ai < 2; ++ai)
#pragma unroll
            for (int m = 0; m < 4; ++m) { const int row = row0 + ai * HALF + m * 16;
                const float* rp = (row < split ? res_lo + (size_t)row * ldc : res_hi + (size_t)(row - split) * ldc) + col0;
                float* rowp = C + (size_t)row * ldc + col0;
#pragma unroll
                for (int bj = 0; bj < 2; ++bj)
#pragma unroll
                    for (int n = 0; n < 2; ++n) { const f32x4 r = *(const f32x4*)(rp + bj * HALF + n * 16); *(f32x4*)(rowp + bj * HALF + n * 16) = acc[ai][bj][m][n] + r; } }
    }
};
template <class Epi, class Sched>
__device__ __forceinline__ void gemm_phase(LAS unsigned char* lds, const Gemm g, const Sched& S, const Epi& E) {
    int tid_ = threadIdx.x; asm volatile("" : "+v"(tid_));
    const int tid = tid_, wid = __builtin_amdgcn_readfirstlane(tid >> 6), lane = tid & 63, wr = wid >> 2, wc = wid & 3, fr = lane & 15, fq = lane >> 4;
    const int K = g.K, nt = K / BK;
    unsigned voffA[2], voffB[2];
#pragma unroll
    for (int i = 0; i < 2; ++i) { int R, C; stage_rc(tid * 16 + i * 8192, R, C); const int Rb = Epi::PERM ? ((R & ~31) + perm32(R & 31)) : R;
        voffA[i] = (unsigned)(R * K + C) * 2u; voffB[i] = (unsigned)(Rb * K + C) * 2u; }
    const size_t kstep = (size_t)(BK * 2);
    const size_t hstep = (size_t)HALF * K * 2;
    const size_t tstep = 2 * hstep;
    const unsigned ldsw = (unsigned)wid * 1024u;
    const int aoff = lds_byte(wr * 64 + fr, fq * 8), boff = lds_byte(wc * 32 + fr, fq * 8);
#define PG8_SA(b, h) (((b) * 2 + (h)) * HTB)
#define PG8_SB(b, h) ((4 + (b) * 2 + (h)) * HTB)
#define PG8_STAGE(bufoff, gbase, voff) do { _Pragma("unroll") for (int _i = 0; _i < 2; ++_i) \
        __builtin_amdgcn_global_load_lds((const unsigned*)((const char*)(gbase) + (voff)[_i]), (LAS unsigned*)(lds + (bufoff) + ldsw + _i * 8192), 16, 0, 0); } while (0)
#define PG8_LDA(dst, b, h) do { _Pragma("unroll") for (int m = 0; m < 4; ++m) _Pragma("unroll") for (int k = 0; k < 2; ++k) dst[m][k] = *(const LAS bf16x8*)(lds + PG8_SA(b, h) + aoff + m * 2048 + k * 1024); } while (0)
#define PG8_LDB(dst, b, h) do { _Pragma("unroll") for (int n = 0; n < 2; ++n) _Pragma("unroll") for (int k = 0; k < 2; ++k) dst[n][k] = *(const LAS bf16x8*)(lds + PG8_SB(b, h) + boff + n * 2048 + k * 1024); } while (0)
#define PG8_MMA(ai, bj, At, Bt) do { __builtin_amdgcn_s_setprio(1); _Pragma("unroll") for (int m = 0; m < 4; ++m) _Pragma("unroll") for (int n = 0; n < 2; ++n) _Pragma("unroll") for (int k = 0; k < 2; ++k) \
        acc[ai][bj][m][n] = __builtin_amdgcn_mfma_f32_16x16x32_bf16(Bt[n][k], At[m][k], acc[ai][bj][m][n], 0, 0, 0); __builtin_amdgcn_s_setprio(0); } while (0)
#define PG8_WAIT_V(n) asm volatile("s_waitcnt vmcnt(" #n ")" ::: "memory")
#define PG8_WAIT_L(n) asm volatile("s_waitcnt lgkmcnt(" #n ")" ::: "memory")
#define PG8_BAR __builtin_amdgcn_s_barrier()
#define PG8_SCHED __builtin_amdgcn_sched_barrier(0)
    Unit cur, nxt; int ui = 0;
    if (!S.next(0, cur)) return;
    f32x4 acc[2][2][4][2];
#pragma unroll
    for (int a = 0; a < 2; ++a)
#pragma unroll
        for (int b = 0; b < 2; ++b)
#pragma unroll
            for (int m = 0; m < 4; ++m)
#pragma unroll
                for (int n = 0; n < 2; ++n) acc[a][b][m][n] = (f32x4){0.f, 0.f, 0.f, 0.f};
    bf16x8 At[4][2], B0[2][2], B1[2][2];
    const char* cA = (const char*)g.A + (size_t)cur.pm * tstep; const char* cB = (const char*)g.Bt + (size_t)cur.pn * tstep;
    PG8_STAGE(PG8_SB(0, 0), cB, voffB); PG8_STAGE(PG8_SB(0, 1), cB + hstep, voffB); PG8_STAGE(PG8_SA(0, 0), cA, voffA); PG8_STAGE(PG8_SA(0, 1), cA + hstep, voffA);
    if (wr == 1) PG8_BAR;
    PG8_WAIT_V(2); PG8_BAR;
    PG8_STAGE(PG8_SB(1, 0), cB + kstep, voffB); PG8_STAGE(PG8_SA(1, 0), cA + kstep, voffA); PG8_STAGE(PG8_SB(1, 1), cB + hstep + kstep, voffB);
    PG8_WAIT_V(6); PG8_BAR;
    for (;;) {
        const bool has_next = S.next(ui + 1, nxt);
        const char* nA = has_next ? (const char*)g.A + (size_t)nxt.pm * tstep : cA; const char* nB = has_next ? (const char*)g.Bt + (size_t)nxt.pn * tstep : cB;
        for (int t = 0; t < nt; t += 2) {
            const bool last = (t == nt - 2);
            const char* a1 = cA + (size_t)(t + 1) * kstep;
            const char* a2 = last ? nA : cA + (size_t)(t + 2) * kstep; const char* b2 = last ? nB : cB + (size_t)(t + 2) * kstep;
            const char* a3 = a2 + kstep; const char* b3 = b2 + kstep;
            PG8_LDB(B0, 0, 0); PG8_LDB(B1, 0, 1); PG8_SCHED; PG8_LDA(At, 0, 0); PG8_STAGE(PG8_SA(1, 1), a1 + hstep, voffA);
            PG8_WAIT_V(8); PG8_WAIT_L(0); PG8_BAR; PG8_MMA(0, 0, At, B0); PG8_MMA(0, 1, At, B1); PG8_BAR; PG8_SCHED;
            PG8_LDA(At, 0, 1); PG8_STAGE(PG8_SB(0, 0), b2, voffB); PG8_STAGE(PG8_SB(0, 1), b2 + hstep, voffB); PG8_STAGE(PG8_SA(0, 0), a2, voffA);
            PG8_WAIT_V(8); PG8_WAIT_L(0); PG8_BAR; PG8_MMA(1, 0, At, B0); PG8_MMA(1, 1, At, B1); PG8_BAR; PG8_SCHED;
            PG8_LDB(B0, 1, 0); PG8_LDB(B1, 1, 1); PG8_SCHED; PG8_LDA(At, 1, 0); PG8_STAGE(PG8_SA(0, 1), a2 + hstep, voffA);
            PG8_WAIT_V(8); PG8_WAIT_L(0); PG8_BAR; PG8_MMA(0, 0, At, B0); PG8_MMA(0, 1, At, B1); PG8_BAR; PG8_SCHED;
            PG8_LDA(At, 1, 1); PG8_STAGE(PG8_SB(1, 0), b3, voffB); PG8_STAGE(PG8_SB(1, 1), b3 + hstep, voffB); PG8_STAGE(PG8_SA(1, 0), a3, voffA);
            PG8_WAIT_V(8); PG8_WAIT_L(0); PG8_BAR; PG8_MMA(1, 0, At, B0); PG8_MMA(1, 1, At, B1); PG8_BAR; PG8_SCHED;
        }
        if (wr == 0) PG8_BAR;
        E(acc, cur, wr, wc, fr, fq);
        if (!has_next) break;
#pragma unroll
        for (int a = 0; a < 2; ++a)
#pragma unroll
            for (int b = 0; b < 2; ++b)
#pragma unroll
                for (int m = 0; m < 4; ++m)
#pragma unroll
                    for (int n = 0; n < 2; ++n) acc[a][b][m][n] = (f32x4){0.f, 0.f, 0.f, 0.f};
        cur = nxt; cA = nA; cB = nB; ++ui;
        if (wr == 1) PG8_BAR;
    }
    PG8_WAIT_V(0);
    PG8_BAR;
#undef PG8_SA
#undef PG8_SB
#undef PG8_STAGE
#undef PG8_LDA
#undef PG8_LDB
#undef PG8_MMA
#undef PG8_WAIT_V
#undef PG8_WAIT_L
#undef PG8_BAR
#undef PG8_SCHED
}
}

namespace att {
constexpr int NW = 8, QBLK = 32, KVBLK = 64;
constexpr float THR = 8.f;
#define SBAR() __builtin_amdgcn_sched_barrier(0)
__device__ __forceinline__ int crow(int r, int hi) { return (r & 3) + 8 * (r >> 2) + 4 * hi; }

template <int DQK> struct Cfg {
    static constexpr float SCALE = DQK == 192 ? 0.07216878364870323f : 0.08838834764831845f;
    static constexpr int KROW = DQK * 2;
    static constexpr size_t SHM_V = KVBLK * 128 * 2, SHM_K = (size_t)KVBLK * DQK * 2;
    static constexpr size_t SHM_TOTAL = 2 * SHM_V + 2 * SHM_K + NW * 64 * 4;
};
template <int DQK> __device__ __forceinline__ int kswz(int row, int colB) {
    if constexpr (DQK == 128) return row * 256 + (colB ^ ((row & 15) << 4));
    else return row * (DQK * 2) + (colB ^ (((row >> 1) & 7) << 4));
}

constexpr float THRL = THR * 1.4426950408889634f;
template <int MODE>
__device__ __forceinline__ void partialSM(f32x16& p0, f32x16& p1, float& m_reg, float& alpha) {
    constexpr bool FIRST = MODE == 1;
    if constexpr (MODE == 2) { alpha = 1.f;
#pragma unroll
        for (int r = 0; r < 16; ++r) p0[r] = __builtin_amdgcn_exp2f(p0[r]);
        return; }
    float pmax = p0[0];
#pragma unroll
    for (int r = 1; r < 16; ++r) pmax = fmaxf(pmax, p0[r]);
#pragma unroll
    for (int r = 0; r < 16; ++r) pmax = fmaxf(pmax, p1[r]);
    { auto rr = __builtin_amdgcn_permlane32_swap(__float_as_uint(pmax), __float_as_uint(pmax), false, false);
      pmax = fmaxf(__uint_as_float(rr[0]), __uint_as_float(rr[1])); }
    if constexpr (FIRST) {
        m_reg = pmax; alpha = 1.f;
#pragma unroll
        for (int r = 0; r < 16; ++r) { p0[r] -= pmax; p1[r] -= pmax; }
    } else {
        if (__builtin_expect(__all(pmax <= THRL), 1)) { alpha = 1.f; }
        else { const float d = fmaxf(pmax, 0.f); alpha = __builtin_amdgcn_exp2f(-d); m_reg += d;
#pragma unroll
            for (int r = 0; r < 16; ++r) { p0[r] -= d; p1[r] -= d; } }
    }
#pragma unroll
    for (int r = 0; r < 16; ++r) p0[r] = __builtin_amdgcn_exp2f(p0[r]);
}
template <bool DEFER>
__device__ __forceinline__ void finishSM(f32x16& p0, f32x16& p1, float alpha, float& l_reg, bf16x8& pa0, bf16x8& pa1, bf16x8& pa2, bf16x8& pa3) {
#pragma unroll
    for (int r = 0; r < 16; ++r) p1[r] = __builtin_amdgcn_exp2f(p1[r]);
    float ps = 0;
#pragma unroll
    for (int r = 0; r < 16; ++r) ps += p0[r];
#pragma unroll
    for (int r = 0; r < 16; ++r) ps += p1[r];
    if constexpr (!DEFER) { auto rr = __builtin_amdgcn_permlane32_swap(__float_as_uint(ps), __float_as_uint(ps), false, false);
      ps = __uint_as_float(rr[0]) + __uint_as_float(rr[1]); }
    l_reg = l_reg * alpha + ps;
#define PK4(P, BASE, OUT) do { u32x4 w = {cvt_pk_bf16(P[BASE + 0], P[BASE + 1]), cvt_pk_bf16(P[BASE + 2], P[BASE + 3]), cvt_pk_bf16(P[BASE + 4], P[BASE + 5]), cvt_pk_bf16(P[BASE + 6], P[BASE + 7])}; \
    OUT = *reinterpret_cast<bf16x8*>(&w); } while (0)
    PK4(p0, 0, pa0); PK4(p0, 8, pa1); PK4(p1, 0, pa2); PK4(p1, 8, pa3);
#undef PK4
}
template <int DQK> struct KB { static constexpr int NB = DQK == 192 ? 4 : 8; int b[NB]; };
template <int DQK, bool ZINIT, bool QREG = false>
__device__ __forceinline__ void qkt(f32x16& p0, f32x16& p1, const char* Ks, const bf16x8* qr, const char* qrl, const KB<DQK>& kb, float negm) {
    if constexpr (!ZINIT) {
#pragma unroll
        for (int r = 0; r < 16; ++r) { p0[r] = negm; p1[r] = negm; } }
    constexpr int NB = KB<DQK>::NB;
#pragma unroll
    for (int d0 = 0; d0 < DQK / 16; ++d0) {
        const char* a = Ks + kb.b[d0 % NB] + (d0 / NB) * (NB * 32);
        bf16x8 b0 = *reinterpret_cast<const bf16x8*>(a);
        bf16x8 b1 = *reinterpret_cast<const bf16x8*>(a + 32 * (DQK * 2));
        bf16x8 q;
        if (d0 < 8 || QREG) q = qr[d0]; else q = *reinterpret_cast<const bf16x8*>(qrl + (d0 - 8) * 1024);
        if (ZINIT && d0 == 0) { p0 = __builtin_amdgcn_mfma_f32_32x32x16_bf16(b0, q, f32x16{}, 0, 0, 0);
                                p1 = __builtin_amdgcn_mfma_f32_32x32x16_bf16(b1, q, f32x16{}, 0, 0, 0); }
        else { p0 = __builtin_amdgcn_mfma_f32_32x32x16_bf16(b0, q, p0, 0, 0, 0);
               p1 = __builtin_amdgcn_mfma_f32_32x32x16_bf16(b1, q, p1, 0, 0, 0); }
    }
}
__device__ __forceinline__ int v_st(int k, int c) { const int kk = k; return ((kk >> 3) * 4 + (c >> 5)) * 512 + ((kk & 7) * 32 + (c & 31)) * 2; }
__device__ __forceinline__ int v_rd_base(int lane) { return ((lane & 3) << 3) | (((lane >> 2) & 3) << 6) | (((lane >> 4) & 1) << 5) | (((lane >> 5) & 1) << 8); }
constexpr int v_rd_off(int d0, int ks, int half) { return d0 * 512 + ks * 4096 + half * 2048; }
template <int OFF> __device__ __forceinline__ s16x4 tr_read(int vb) {
    s16x4 r; asm volatile("ds_read_b64_tr_b16 %0, %1 offset:%2" : "=&v"(r) : "v"(vb), "i"(OFF) : "memory"); return r;
}
template <int D0> __device__ __forceinline__ void pv_one(f32x16& od, int vb, bf16x8 pa0, bf16x8 pa1, bf16x8 pa2, bf16x8 pa3) {
    const s16x4 l0 = tr_read<v_rd_off(D0, 0, 0)>(vb), h0 = tr_read<v_rd_off(D0, 0, 1)>(vb), l1 = tr_read<v_rd_off(D0, 1, 0)>(vb), h1 = tr_read<v_rd_off(D0, 1, 1)>(vb);
    const s16x4 l2 = tr_read<v_rd_off(D0, 2, 0)>(vb), h2 = tr_read<v_rd_off(D0, 2, 1)>(vb), l3 = tr_read<v_rd_off(D0, 3, 0)>(vb), h3 = tr_read<v_rd_off(D0, 3, 1)>(vb);
    asm volatile("s_waitcnt lgkmcnt(0)" ::: "memory"); SBAR();
#define PK(L, H) (bf16x8){L[0], L[1], L[2], L[3], H[0], H[1], H[2], H[3]}
    od = __builtin_amdgcn_mfma_f32_32x32x16_bf16(pa0, PK(l0, h0), od, 0, 0, 0);
    od = __builtin_amdgcn_mfma_f32_32x32x16_bf16(pa1, PK(l1, h1), od, 0, 0, 0);
    od = __builtin_amdgcn_mfma_f32_32x32x16_bf16(pa2, PK(l2, h2), od, 0, 0, 0);
    od = __builtin_amdgcn_mfma_f32_32x32x16_bf16(pa3, PK(l3, h3), od, 0, 0, 0);
#undef PK
}
__device__ __forceinline__ void pv_d0(f32x16* o, int vb, bf16x8 pa0, bf16x8 pa1, bf16x8 pa2, bf16x8 pa3) {
    pv_one<0>(o[0], vb, pa0, pa1, pa2, pa3); pv_one<1>(o[1], vb, pa0, pa1, pa2, pa3); pv_one<2>(o[2], vb, pa0, pa1, pa2, pa3); pv_one<3>(o[3], vb, pa0, pa1, pa2, pa3);
}

template <int LDO>
__device__ __forceinline__ void epilogue(const f32x16 (&o)[4], bf16_t* __restrict__ Ob, char* wsbase) {
    int tid_ = threadIdx.x; asm volatile("" : "+v"(tid_));
    const int wid = tid_ >> 6, lane = tid_ & 63, r32 = lane & 31, hi = lane >> 5;
    const float* li_l = (const float*)wsbase + wid * 64;
    float rli[16];
#pragma unroll
    for (int r = 0; r < 16; ++r) rli[r] = __builtin_amdgcn_rcpf(li_l[crow(r, hi)]);
    GAS bf16_t* Ow = (GAS bf16_t*)Ob + (long)(wid * QBLK) * LDO;
#pragma unroll
    for (int r = 0; r < 16; ++r) { const int orow = crow(r, hi);
#pragma unroll
        for (int d0 = 0; d0 < 4; ++d0) Ow[(long)orow * LDO + d0 * 32 + r32] = f2bf(o[d0][r] * rli[r]); }
}
template <int DQK, int LDQ, int LDK, int LDV, int LDO, int SDEPTH, bool NOMAX = false>
__device__ __forceinline__ void attn_body(const bf16_t* __restrict__ Qb_, const bf16_t* __restrict__ Kh_, const bf16_t* __restrict__ Krh_, const bf16_t* __restrict__ Vh_,
                                          bf16_t* __restrict__ Ob, int seq, int qpos0, char* lds) {
    using C = Cfg<DQK>;
    const GAS bf16_t* Qb = (const GAS bf16_t*)Qb_; const GAS bf16_t* Kh = (const GAS bf16_t*)Kh_; const GAS bf16_t* Krh = (const GAS bf16_t*)Krh_; const GAS bf16_t* Vh = (const GAS bf16_t*)Vh_;
    constexpr size_t SHM_V = C::SHM_V, SHM_K = C::SHM_K;
    constexpr bool HASR = DQK == 192;
    constexpr bool QREG = HASR && NOMAX;
    int tid_ = threadIdx.x; asm volatile("" : "+v"(tid_));
    const int tid = tid_, wid = tid >> 6, lane = tid & 63, r32 = lane & 31, hi = lane >> 5;
    char* V_lds = lds; char* K_lds = lds + 2 * SHM_V;
    float* ws = (float*)(lds + 2 * SHM_V + 2 * SHM_K) + wid * 64; float* li_l = ws; float* al_l = ws + 32;
    float m_reg = 0.f, l_reg = 0; f32x16 o[4] = {}; bf16x8 qr[QREG ? 12 : 8];
    const GAS bf16_t* Qw = Qb + (long)(wid * QBLK + r32) * LDQ + hi * 8;
    constexpr float QC = C::SCALE * 1.4426950408889634f;
#pragma unroll
    for (int d0 = 0; d0 < 8; ++d0) { const bf16x8 q = *(const GAS bf16x8*)(Qw + d0 * 16);
        u32x4 w; w.x = cvt_pk_bf16(bf2f((bf16_t)q[0]) * QC, bf2f((bf16_t)q[1]) * QC); w.y = cvt_pk_bf16(bf2f((bf16_t)q[2]) * QC, bf2f((bf16_t)q[3]) * QC);
        w.z = cvt_pk_bf16(bf2f((bf16_t)q[4]) * QC, bf2f((bf16_t)q[5]) * QC); w.w = cvt_pk_bf16(bf2f((bf16_t)q[6]) * QC, bf2f((bf16_t)q[7]) * QC);
        qr[d0] = *reinterpret_cast<bf16x8*>(&w); }
    char* qrl = lds + 2 * SHM_V + 2 * SHM_K + NW * 64 * 4 + (wid * 4 * 64 + lane) * 16;
    if constexpr (HASR) {
        const int s = qpos0 + wid * QBLK + r32; const float prow = (float)(s >> 6), pcol = (float)(s & 63);
        const bf16x8 q8 = *(const GAS bf16x8*)(Qw + 128), q9 = *(const GAS bf16x8*)(Qw + 144),
                     q10 = *(const GAS bf16x8*)(Qw + 160), q11 = *(const GAS bf16x8*)(Qw + 176);
        float a1[8], a2[8], b1[8], b2[8];
#pragma unroll
        for (int e = 0; e < 8; ++e) { const float f = __builtin_amdgcn_exp2f(-(float)(hi * 8 + e) * (LOG2_THETA / 16.f));
            float sn, cs; sincos_hw(prow * f, sn, cs);
            float x1 = bf2f((bf16_t)q8[e]) * QC, x2 = bf2f((bf16_t)q9[e]) * QC; a1[e] = x1 * cs - x2 * sn; a2[e] = x2 * cs + x1 * sn;
            sincos_hw(pcol * f, sn, cs);
            x1 = bf2f((bf16_t)q10[e]) * QC; x2 = bf2f((bf16_t)q11[e]) * QC; b1[e] = x1 * cs - x2 * sn; b2[e] = x2 * cs + x1 * sn; }
        const u32x4 w0 = (u32x4){cvt_pk_bf16(a1[0], a1[1]), cvt_pk_bf16(a1[2], a1[3]), cvt_pk_bf16(a1[4], a1[5]), cvt_pk_bf16(a1[6], a1[7])};
        const u32x4 w1 = (u32x4){cvt_pk_bf16(a2[0], a2[1]), cvt_pk_bf16(a2[2], a2[3]), cvt_pk_bf16(a2[4], a2[5]), cvt_pk_bf16(a2[6], a2[7])};
        const u32x4 w2 = (u32x4){cvt_pk_bf16(b1[0], b1[1]), cvt_pk_bf16(b1[2], b1[3]), cvt_pk_bf16(b1[4], b1[5]), cvt_pk_bf16(b1[6], b1[7])};
        const u32x4 w3 = (u32x4){cvt_pk_bf16(b2[0], b2[1]), cvt_pk_bf16(b2[2], b2[3]), cvt_pk_bf16(b2[4], b2[5]), cvt_pk_bf16(b2[6], b2[7])};
        if constexpr (QREG) { qr[QREG ? 8 : 0] = *reinterpret_cast<const bf16x8*>(&w0); qr[QREG ? 9 : 0] = *reinterpret_cast<const bf16x8*>(&w1);
                              qr[QREG ? 10 : 0] = *reinterpret_cast<const bf16x8*>(&w2); qr[QREG ? 11 : 0] = *reinterpret_cast<const bf16x8*>(&w3); }
        else { *(u32x4*)(qrl) = w0; *(u32x4*)(qrl + 1024) = w1; *(u32x4*)(qrl + 2048) = w2; *(u32x4*)(qrl + 3072) = w3; }
    }
    const int sr = tid >> 4, sc = (tid & 15) * 8, vst0 = v_st(sr, sc), vst1 = v_st(32 + sr, sc);
    const int rr_ = tid >> 3, rc_ = (tid & 7) * 8;
    const int vb0 = (int)(uintptr_t)V_lds + v_rd_base(lane);
    KB<DQK> kb;
#pragma unroll
    for (int q = 0; q < KB<DQK>::NB; ++q) kb.b[q] = kswz<DQK>(r32, (q * 16 + hi * 8) * 2);
    struct { bf16x8 vs0, vs1, ks0, ks1, kr; } sr_[SDEPTH];
#define SLOAD(i, k0) do { sr_[i].vs0 = *(const GAS bf16x8*)(&Vh[(long)((k0) + sr) * LDV + sc]); sr_[i].vs1 = *(const GAS bf16x8*)(&Vh[(long)((k0) + 32 + sr) * LDV + sc]); \
    sr_[i].ks0 = *(const GAS bf16x8*)(&Kh[(long)((k0) + sr) * LDK + sc]); sr_[i].ks1 = *(const GAS bf16x8*)(&Kh[(long)((k0) + 32 + sr) * LDK + sc]); \
    if constexpr (HASR) sr_[i].kr = *(const GAS bf16x8*)(&Krh[(long)((k0) + rr_) * 64 + rc_]); } while (0)
#define SWRITE(b, i) do { *(bf16x8*)(V_lds + (b) * SHM_V + vst0) = sr_[i].vs0;          \
    *(bf16x8*)(V_lds + (b) * SHM_V + vst1) = sr_[i].vs1; const int kc = sc * 2;               \
    *(bf16x8*)(K_lds + (b) * SHM_K + kswz<DQK>(sr, kc)) = sr_[i].ks0;                       \
    *(bf16x8*)(K_lds + (b) * SHM_K + kswz<DQK>(32 + sr, kc)) = sr_[i].ks1;                  \
    if constexpr (HASR) *(bf16x8*)(K_lds + (b) * SHM_K + kswz<DQK>(rr_, 256 + rc_ * 2)) = sr_[i].kr; } while (0)
#define SWAIT() do { if constexpr (SDEPTH == 2) { if constexpr (HASR) asm volatile("s_waitcnt vmcnt(5)" ::: "memory"); else asm volatile("s_waitcnt vmcnt(4)" ::: "memory"); } \
    else asm volatile("s_waitcnt vmcnt(0)" ::: "memory"); } while (0)
#define RESC(a) do { if constexpr (!NOMAX) if (__any((a) < 1.f)) { if (hi == 0) al_l[r32] = (a); asm volatile("s_waitcnt lgkmcnt(0)" ::: "memory"); \
    _Pragma("unroll") for (int d = 0; d < 4; ++d) _Pragma("unroll") for (int r = 0; r < 16; ++r) o[d][r] *= al_l[crow(r, hi)]; } } while (0)
    f32x16 pA0, pA1, pB0, pB1; float alA, alB; bf16x8 pa0, pa1, pa2, pa3; const int NT = seq / KVBLK;
    constexpr int SE = 0, SO = SDEPTH - 1;
    SLOAD(SE, 0); asm volatile("s_waitcnt vmcnt(0)" ::: "memory"); SWRITE(0, SE); __syncthreads();
    qkt<DQK, NOMAX, QREG>(pA0, pA1, K_lds, qr, qrl, kb, 0.f); partialSM<NOMAX ? 2 : 1>(pA0, pA1, m_reg, alA);
    SLOAD(SO, KVBLK); if constexpr (SDEPTH == 2) { if (2 < NT) SLOAD(SE, 2 * KVBLK); }
    SWAIT(); SWRITE(1, SO); __syncthreads();
    for (int j = 1; j + 1 < NT; j += 2) {
        SBAR(); qkt<DQK, NOMAX, QREG>(pB0, pB1, K_lds + SHM_K, qr, qrl, kb, -m_reg);
        finishSM<NOMAX>(pA0, pA1, alA, l_reg, pa0, pa1, pa2, pa3); SBAR();
        SLOAD(SO, (j + SDEPTH) * KVBLK); SBAR();
        pv_d0(o, vb0, pa0, pa1, pa2, pa3); partialSM<NOMAX ? 2 : 0>(pB0, pB1, m_reg, alB);
        __syncthreads(); SWAIT(); SWRITE(0, SE);
        RESC(alB); __syncthreads();
        SBAR(); qkt<DQK, NOMAX, QREG>(pA0, pA1, K_lds, qr, qrl, kb, -m_reg);
        finishSM<NOMAX>(pB0, pB1, alB, l_reg, pa0, pa1, pa2, pa3); SBAR();
        if (SDEPTH == 1 || j + 3 < NT) SLOAD(SE, (j + 1 + SDEPTH) * KVBLK); SBAR();
        pv_d0(o, vb0 + (int)SHM_V, pa0, pa1, pa2, pa3); partialSM<NOMAX ? 2 : 0>(pA0, pA1, m_reg, alA);
        __syncthreads(); SWAIT(); SWRITE(1, SO);
        RESC(alA); __syncthreads();
    }
    SBAR(); qkt<DQK, NOMAX, QREG>(pB0, pB1, K_lds + SHM_K, qr, qrl, kb, -m_reg);
    finishSM<NOMAX>(pA0, pA1, alA, l_reg, pa0, pa1, pa2, pa3); SBAR();
    pv_d0(o, vb0, pa0, pa1, pa2, pa3); partialSM<NOMAX ? 2 : 0>(pB0, pB1, m_reg, alB);
    __syncthreads(); RESC(alB);
    finishSM<NOMAX>(pB0, pB1, alB, l_reg, pa0, pa1, pa2, pa3); SBAR();
    pv_d0(o, vb0 + (int)SHM_V, pa0, pa1, pa2, pa3);
    if constexpr (NOMAX) { auto rr = __builtin_amdgcn_permlane32_swap(__float_as_uint(l_reg), __float_as_uint(l_reg), false, false); l_reg = __uint_as_float(rr[0]) + __uint_as_float(rr[1]); }
    if (hi == 0) li_l[r32] = l_reg; asm volatile("s_waitcnt lgkmcnt(0)" ::: "memory");
    epilogue<LDO>(o, Ob, lds + 2 * SHM_V + 2 * SHM_K);
    asm volatile("s_waitcnt vmcnt(0)" ::: "memory");
    __syncthreads();
#undef SLOAD
#undef SWRITE
#undef SWAIT
#undef RESC
}
#if 0
    float rli[16];
#pragma unroll
    for (int r = 0; r < 16; ++r) rli[r] = __builtin_amdgcn_rcpf(li_l[crow(r, hi)]);
    bf16_t* Ow = Ob + (long)(wid * QBLK) * LDO;
#pragma unroll
    for (int r = 0; r < 16; ++r) { const int orow = crow(r, hi);
#pragma unroll
        for (int d0 = 0; d0 < 4; ++d0) Ow[(long)orow * LDO + d0 * 32 + r32] = f2bf(o[d0][r] * rli[r]); }
    asm volatile("s_waitcnt vmcnt(0)" ::: "memory");
    __syncthreads();
#endif
}

#define XB_TMO      128
#define XB_XCNT(j)  (256  + 64 * (j))
#define XB_XSUB(j)  (1280 + 64 * (j))
#define XB_XGEN(j)  (2304 + 64 * (j))
#define XB_TOP      3328
#define XB_TOPGEN   3392
#define XCD_BAR_WORDS 3456
#define XB_SPIN_CAP (1u << 22)
__device__ __forceinline__ unsigned xb_ld(unsigned* p)              { return __hip_atomic_load(p, __ATOMIC_RELAXED, __HIP_MEMORY_SCOPE_AGENT); }
__device__ __forceinline__ unsigned xb_add(unsigned* p, unsigned v) { return __hip_atomic_fetch_add(p, v, __ATOMIC_RELAXED, __HIP_MEMORY_SCOPE_AGENT); }
__device__ __forceinline__ unsigned xb_xcc_id() { return (unsigned)__builtin_amdgcn_s_getreg((3 << 11) | 20) & 0xFu; }
#define XB_SPIN(cond, bar) do { unsigned _sp = 0; while (cond) { __builtin_amdgcn_s_sleep(1); \
    if ((++_sp & 255u) == 0u) { if (xb_ld(&(bar)[XB_TMO])) break; if (_sp > XB_SPIN_CAP) { atomicAdd(&(bar)[XB_TMO], 1u); break; } } } } while (0)
struct XcdBarrier { unsigned* bar; unsigned x; volatile LAS unsigned* st; };
__device__ __forceinline__ XcdBarrier xcd_barrier_post(unsigned* bar, volatile LAS unsigned* st) {
    XcdBarrier b; b.bar = bar; b.x = xb_xcc_id(); b.st = st;
    if (threadIdx.x == 0) (void)xb_add(&bar[XB_XCNT(b.x)], 1u);
    return b;
}
__device__ __forceinline__ void xcd_barrier_complete(unsigned* bar, unsigned x, unsigned& nloc, unsigned& nx) {
    const unsigned G = gridDim.x * gridDim.y * gridDim.z;
    unsigned sum, cnt, mine, sp = 0u;
    for (;;) {
        sum = 0u; cnt = 0u; mine = 0u;
#pragma unroll
        for (unsigned j = 0; j < 16; ++j) { const unsigned c = xb_ld(&bar[XB_XCNT(j)]); sum += c; cnt += (c > 0u) ? 1u : 0u; mine = (j == x) ? c : mine; }
        if (sum == G) break;
        __builtin_amdgcn_s_sleep(1);
        if ((++sp & 255u) == 0u) { if (xb_ld(&bar[XB_TMO])) break; if (sp > XB_SPIN_CAP) { atomicAdd(&bar[XB_TMO], 1u); break; } }
    }
    nloc = mine > 0u ? mine : 1u; nx = cnt > 0u ? cnt : 1u;
}
__device__ __forceinline__ void xcd_barrier(const XcdBarrier& b) {
    asm volatile("s_waitcnt vmcnt(0)" ::: "memory");
    __syncthreads();
    if (threadIdx.x == 0) {
        unsigned* bar = b.bar; asm volatile("" : "+s"(bar));
        __builtin_amdgcn_s_waitcnt(0);
        unsigned nloc = b.st[0], nx = b.st[1];
        if (nloc == 0u) { xcd_barrier_complete(bar, b.x, nloc, nx); b.st[0] = nloc; b.st[1] = nx; }
        const unsigned old = xb_add(&bar[XB_XSUB(b.x)], 1u);
        const unsigned gen = old / nloc;
        if (old + 1u == (gen + 1u) * nloc) {
            __builtin_amdgcn_fence(__ATOMIC_RELEASE, "agent");
            asm volatile("s_waitcnt vmcnt(0)" ::: "memory");
            const unsigned og = xb_add(&bar[XB_TOP], 1u);
            const unsigned tg = og / nx;
            if (og + 1u == (tg + 1u) * nx) xb_add(&bar[XB_TOPGEN], 1u);
            else XB_SPIN(xb_ld(&bar[XB_TOPGEN]) == tg, bar);
            __builtin_amdgcn_fence(__ATOMIC_ACQUIRE, "agent");
            xb_add(&bar[XB_XGEN(b.x)], 1u);
            asm volatile("s_waitcnt vmcnt(0)" ::: "memory");
        } else {
            XB_SPIN(xb_ld(&bar[XB_XGEN(b.x)]) == gen, bar);
            __builtin_amdgcn_fence(__ATOMIC_ACQUIRE, "agent");
            asm volatile("s_waitcnt vmcnt(0)" ::: "memory");
        }
    }
    __syncthreads();
}

struct Params {
    const float* in[15];
    float* out;
    unsigned char* ws;
    int ph_lo, ph_hi;
};

__device__ __forceinline__ void transpose_item(const float* W, int K, int N, bf16_t* WT, LAS float* scr, int item, int lane, const float* gain = nullptr) {
    const int nblk = N / 32, kb = item / nblk, nb = item % nblk, k0 = 64 * kb, n0 = 32 * nb;
#pragma unroll 8
    for (int i = 0; i < 32; ++i) { const int kk = 2 * i + (lane >> 5); scr[kk * 33 + (lane & 31)] = W[(size_t)(k0 + kk) * N + n0 + (lane & 31)]; }
    asm volatile("s_waitcnt lgkmcnt(0)" ::: "memory");
    const int c = lane & 7;
    f32x4 g0 = {1.f, 1.f, 1.f, 1.f}, g1 = g0;
    if (gain) { g0 = *(const f32x4*)(gain + k0 + 8 * c); g1 = *(const f32x4*)(gain + k0 + 8 * c + 4); }
#pragma unroll
    for (int j = 0; j < 4; ++j) { const int n = (lane >> 3) + 8 * j; const LAS float* s = scr + (8 * c) * 33 + n;
        u32x4 o; o.x = cvt_pk_bf16(s[0 * 33] * g0[0], s[1 * 33] * g0[1]); o.y = cvt_pk_bf16(s[2 * 33] * g0[2], s[3 * 33] * g0[3]); o.z = cvt_pk_bf16(s[4 * 33] * g1[0], s[5 * 33] * g1[1]); o.w = cvt_pk_bf16(s[6 * 33] * g1[2], s[7 * 33] * g1[3]);
        *(u32x4*)(WT + (size_t)(n0 + n) * K + k0 + 8 * c) = o; }
    asm volatile("s_waitcnt lgkmcnt(0)" ::: "memory");
}

__device__ __forceinline__ void phase_weights(const Params& p, int layer, LAS unsigned char* lds, int gw, int NGW, int wave, int lane) {
    LAS float* scr = (LAS float*)(lds + wave * 8704);
    size_t wz_ = 0; asm volatile("" : "+s"(wz_)); unsigned char* ws = p.ws + wz_;
    const float* w_in = p.in[3] + (size_t)layer * DM * INW;
    const float* w_q = p.in[5] + (size_t)layer * QLORA * QA_W;
    const float* w_kv = p.in[7] + (size_t)layer * KVLORA * KVA_W;
    const float* w_o = p.in[10] + (size_t)layer * DM * DM;
    const float* w_up = p.in[12] + (size_t)layer * DM * DFF;
    const float* w_dn = p.in[13] + (size_t)layer * DFF * DM;
    constexpr int I_IN = (DM / 64) * (INW / 32), I_Q = (QLORA / 64) * (QA_W / 32), I_KV = (KVLORA / 64) * (KVA_W / 32), I_O = (DM / 64) * (DM / 32),
                  I_UP = (DM / 64) * (DFF / 32), I_DN = (DFF / 64) * (DM / 32), NITEMS = I_IN + I_Q + I_KV + I_O + I_UP + I_DN;
    for (int it = gw; it < NITEMS; it += NGW) {
        int r = it;
        if (r < I_IN) { transpose_item(w_in, DM, INW, (bf16_t*)(ws + W_IN), scr, r, lane); continue; } r -= I_IN;
        if (r < I_Q) { transpose_item(w_q, QLORA, QA_W, (bf16_t*)(ws + W_Q), scr, r, lane); continue; } r -= I_Q;
        if (r < I_KV) { transpose_item(w_kv, KVLORA, KVA_W, (bf16_t*)(ws + W_KV), scr, r, lane); continue; } r -= I_KV;
        if (r < I_O) { transpose_item(w_o, DM, DM, (bf16_t*)(ws + W_O), scr, r, lane); continue; } r -= I_O;
        if (r < I_UP) { transpose_item(w_up, DM, DFF, (bf16_t*)(ws + W_UP), scr, r, lane, p.in[11] + layer * DM); continue; } r -= I_UP;
        transpose_item(w_dn, DFF, DM, (bf16_t*)(ws + W_DN), scr, r, lane);
    }
    u32x4* pad = (u32x4*)(ws + W_IN + (size_t)INW * DM * 2);
    unsigned zz = 0u; asm volatile("" : "+v"(zz));
    for (int i = gw * 64 + lane; i < 64 * DM * 2 / 16; i += NGW * 64) pad[i] = (u32x4){zz, zz, zz, zz};
}

__device__ __forceinline__ void ld8f(const bf16_t* p, float (&v)[8]) {
    const u32x4 w = *(const u32x4*)p;
    v[0] = __uint_as_float(w.x << 16); v[1] = __uint_as_float(w.x & 0xffff0000u); v[2] = __uint_as_float(w.y << 16); v[3] = __uint_as_float(w.y & 0xffff0000u);
    v[4] = __uint_as_float(w.z << 16); v[5] = __uint_as_float(w.z & 0xffff0000u); v[6] = __uint_as_float(w.w << 16); v[7] = __uint_as_float(w.w & 0xffff0000u);
}
__device__ __forceinline__ void st8f(bf16_t* p, const float (&v)[8]) {
    u32x4 w; w.x = cvt_pk_bf16(v[0], v[1]); w.y = cvt_pk_bf16(v[2], v[3]); w.z = cvt_pk_bf16(v[4], v[5]); w.w = cvt_pk_bf16(v[6], v[7]); *(u32x4*)p = w;
}
__device__ __forceinline__ void rms_row_to_bf16(const float* xrow, const f32x4 (&g)[4], bf16_t* orow, int lane) {
    const f32x4* xr = (const f32x4*)xrow + lane;
    f32x4 v[4]; float s = 0.f;
#pragma unroll
    for (int j = 0; j < 4; ++j) { v[j] = xr[64 * j]; s += (v[j].x * v[j].x + v[j].y * v[j].y) + (v[j].z * v[j].z + v[j].w * v[j].w); }
    const float rstd = 1.f / sqrtf(wave_sum(s) * (1.f / DM) + EPS);
    u32x2* o8 = (u32x2*)orow + lane;
#pragma unroll
    for (int j = 0; j < 4; ++j) { u32x2 w; w.x = cvt_pk_bf16(v[j].x * rstd * g[j].x, v[j].y * rstd * g[j].y); w.y = cvt_pk_bf16(v[j].z * rstd * g[j].z, v[j].w * rstd * g[j].w); o8[64 * j] = w; }
}
__device__ __forceinline__ void phase_norm(const float* x_lo, const float* x_hi, const float* gain, bf16_t* H, int gw, int NGW, int lane) {
    f32x4 g[4];
#pragma unroll
    for (int j = 0; j < 4; ++j) g[j] = ((const f32x4*)gain)[lane + 64 * j];
    for (int m = gw; m < T; m += NGW) {
        const float* xr = m < T_PROMPT ? x_lo + (size_t)m * DM : x_hi + (size_t)(m - T_PROMPT) * DM;
        rms_row_to_bf16(xr, g, H + (size_t)m * DM, lane);
    }
}
__device__ __forceinline__ void phase_norm_b16(const bf16_t* Xb, const float* gain, bf16_t* H, int gw, int NGW, int lane) {
    f32x4 g[4];
#pragma unroll
    for (int j = 0; j < 2; ++j) { g[2 * j] = *(const f32x4*)(gain + 512 * j + 8 * lane); g[2 * j + 1] = *(const f32x4*)(gain + 512 * j + 8 * lane + 4); }
    for (int m = gw; m < T; m += NGW) {
        float v[2][8]; float s = 0.f;
#pragma unroll
        for (int j = 0; j < 2; ++j) { ld8f(Xb + (size_t)m * DM + 512 * j + 8 * lane, v[j]);
#pragma unroll
            for (int e = 0; e < 8; ++e) s += v[j][e] * v[j][e]; }
        const float rstd = 1.f / sqrtf(wave_sum(s) * (1.f / DM) + EPS);
#pragma unroll
        for (int j = 0; j < 2; ++j) {
#pragma unroll
            for (int e = 0; e < 8; ++e) v[j][e] *= rstd * g[2 * j + (e >> 2)][e & 3];
            st8f(H + (size_t)m * DM + 512 * j + 8 * lane, v[j]); }
    }
}
__device__ __forceinline__ void phase_rowstats(const bf16_t* Xb, float* RS, int gw, int NGW, int lane) {
    for (int m = gw; m < T; m += NGW) {
        float v[2][8]; float s = 0.f;
#pragma unroll
        for (int j = 0; j < 2; ++j) { ld8f(Xb + (size_t)m * DM + 512 * j + 8 * lane, v[j]);
#pragma unroll
            for (int e = 0; e < 8; ++e) s += v[j][e] * v[j][e]; }
        const float rstd = 1.f / sqrtf(wave_sum(s) * (1.f / DM) + EPS);
        if (lane == 0) RS[m] = rstd;
    }
}
__device__ __forceinline__ void phase_final_norm_b16(const bf16_t* Xb, float* out, const float* gain, int gw, int NGW, int lane) {
    f32x4 g[4];
#pragma unroll
    for (int j = 0; j < 2; ++j) { g[2 * j] = *(const f32x4*)(gain + 512 * j + 8 * lane); g[2 * j + 1] = *(const f32x4*)(gain + 512 * j + 8 * lane + 4); }
    for (int m = gw; m < T; m += NGW) {
        float v[2][8]; float s = 0.f;
#pragma unroll
        for (int j = 0; j < 2; ++j) { ld8f(Xb + (size_t)m * DM + 512 * j + 8 * lane, v[j]);
#pragma unroll
            for (int e = 0; e < 8; ++e) s += v[j][e] * v[j][e]; }
        const float rstd = 1.f / sqrtf(wave_sum(s) * (1.f / DM) + EPS);
#pragma unroll
        for (int j = 0; j < 2; ++j) { float* o = out + (size_t)m * DM + 512 * j + 8 * lane;
            *(f32x4*)o = (f32x4){v[j][0], v[j][1], v[j][2], v[j][3]} * rstd * g[2 * j];
            *(f32x4*)(o + 4) = (f32x4){v[j][4], v[j][5], v[j][6], v[j][7]} * rstd * g[2 * j + 1]; }
    }
}
__device__ __forceinline__ void phase_final_norm(float* X, const float* gain, int gw, int NGW, int lane) {
    f32x4 g[4];
#pragma unroll
    for (int j = 0; j < 4; ++j) g[j] = ((const f32x4*)gain)[lane + 64 * j];
    for (int m = gw; m < T; m += NGW) {
        f32x4* xr = (f32x4*)(X + (size_t)m * DM) + lane;
        f32x4 v[4]; float s = 0.f;
#pragma unroll
        for (int j = 0; j < 4; ++j) { v[j] = xr[64 * j]; s += (v[j].x * v[j].x + v[j].y * v[j].y) + (v[j].z * v[j].z + v[j].w * v[j].w); }
        const float rstd = 1.f / sqrtf(wave_sum(s) * (1.f / DM) + EPS);
#pragma unroll
        for (int j = 0; j < 4; ++j) xr[64 * j] = v[j] * rstd * g[j];
    }
}

__device__ __forceinline__ float sum8lanes(float v) { const int l = lane_opaque(); v += shx(v, 1, l); v += shx(v, 2, l); v += shx(v, 4, l); return v; }
__device__ __forceinline__ void head_norm_rope(const bf16_t* za, const float* g, bf16_t* out, int sl, const float (&sr)[8], const float (&cr)[8], const float (&sc)[8], const float (&cc)[8]) {
    float a[8], b[8], ga[8], gb[8]; ld8f(za, a); ld8f(za + 64, b);
    *(f32x4*)&ga[0] = *(const f32x4*)(g + 8 * sl); *(f32x4*)&ga[4] = *(const f32x4*)(g + 8 * sl + 4);
    *(f32x4*)&gb[0] = *(const f32x4*)(g + 64 + 8 * sl); *(f32x4*)&gb[4] = *(const f32x4*)(g + 64 + 8 * sl + 4);
    float ss = 0.f;
#pragma unroll
    for (int e = 0; e < 8; ++e) ss += a[e] * a[e] + b[e] * b[e];
    const float rstd = 1.f / sqrtf(sum8lanes(ss) * (1.f / HD) + EPS);
    const bool second = sl >= 4; const int ln = lane_opaque();
#pragma unroll
    for (int e = 0; e < 8; ++e) { const float xa = a[e] * rstd * ga[e], xb = b[e] * rstd * gb[e];
        const float ya = shx(xa, 4, ln), yb = shx(xb, 4, ln);
        a[e] = second ? (xa * cr[e] + ya * sr[e]) : (xa * cr[e] - ya * sr[e]);
        b[e] = second ? (xb * cc[e] + yb * sc[e]) : (xb * cc[e] - yb * sc[e]); }
    st8f(out, a); st8f(out + 64, b);
}
__device__ __forceinline__ void phase_post(const Params& p, int layer, int gw, int NGW, int lane) {
    size_t wz_ = 0; asm volatile("" : "+s"(wz_)); unsigned char* ws = p.ws + wz_;
    const bf16_t* Z = (const bf16_t*)(ws + A_Z);
    bf16_t* CQN = (bf16_t*)(ws + A_CQN); bf16_t* CKVN = (bf16_t*)(ws + A_CKVN); bf16_t* KR = (bf16_t*)(ws + A_KR);
    bf16_t* QB = (bf16_t*)(ws + A_QB); bf16_t* KB = (bf16_t*)(ws + A_KB); bf16_t* VB = (bf16_t*)(ws + A_VB);
    const float* gq = p.in[4] + layer * QLORA; const float* gkv = p.in[6] + layer * KVLORA;
    const float* gbq = p.in[8] + layer * HD; const float* gbk = p.in[9] + layer * HD;
    const int sl = lane & 7, tw = lane >> 3;
    float f64[8], f32_[8];
#pragma unroll
    for (int e = 0; e < 8; ++e) { f64[e] = __builtin_amdgcn_exp2f(-(float)(8 * (sl & 3) + e) * (LOG2_THETA / 32.f));
                                  f32_[e] = __builtin_amdgcn_exp2f(-(float)(8 * (sl & 1) + e) * (LOG2_THETA / 16.f)); }
    float krmax = 0.f;
    for (int grp = gw; grp < T / 8; grp += NGW) {
        const int tok = grp * 8 + tw;
        const bf16_t* z = Z + (size_t)tok * INW_PAD + 8 * sl;
        const int s = seq_pos(tok); const float prow = (float)(s >> 6), pcol = (float)(s & 63);
        { float v[6][8]; float ss = 0.f;
#pragma unroll
          for (int c = 0; c < 6; ++c) { ld8f(z + 64 * c, v[c]);
#pragma unroll
              for (int e = 0; e < 8; ++e) ss += v[c][e] * v[c][e]; }
          const float rstd = 1.f / sqrtf(sum8lanes(ss) * (1.f / QLORA) + EPS);
#pragma unroll
          for (int c = 0; c < 6; ++c) { float g[8]; *(f32x4*)&g[0] = *(const f32x4*)(gq + 64 * c + 8 * sl); *(f32x4*)&g[4] = *(const f32x4*)(gq + 64 * c + 8 * sl + 4);
#pragma unroll
              for (int e = 0; e < 8; ++e) v[c][e] *= rstd * g[e];
              st8f(CQN + (size_t)tok * QLORA + 64 * c + 8 * sl, v[c]); } }
        { float v[4][8]; float ss = 0.f;
#pragma unroll
          for (int c = 0; c < 4; ++c) { ld8f(z + 64 * (6 + c), v[c]);
#pragma unroll
              for (int e = 0; e < 8; ++e) ss += v[c][e] * v[c][e]; }
          const float rstd = 1.f / sqrtf(sum8lanes(ss) * (1.f / KVLORA) + EPS);
#pragma unroll
          for (int c = 0; c < 4; ++c) { float g[8]; *(f32x4*)&g[0] = *(const f32x4*)(gkv + 64 * c + 8 * sl); *(f32x4*)&g[4] = *(const f32x4*)(gkv + 64 * c + 8 * sl + 4);
#pragma unroll
              for (int e = 0; e < 8; ++e) v[c][e] *= rstd * g[e];
              st8f(CKVN + (size_t)tok * KVLORA + 64 * c + 8 * sl, v[c]); } }
        { float x[8]; ld8f(z + 640, x); const float pos = sl < 4 ? prow : pcol; const bool second = (sl & 2) != 0; const int lnk = lane_opaque();
#pragma unroll
          for (int e = 0; e < 8; ++e) { float sn, cs; sincos_hw(pos * f32_[e], sn, cs); const float y = shx(x[e], 2, lnk);
              x[e] = second ? (x[e] * cs + y * sn) : (x[e] * cs - y * sn); }
          st8f(KR + (size_t)tok * ROPE + 8 * sl, x);
          float ss = 0.f;
#pragma unroll
          for (int e = 0; e < 8; ++e) ss += x[e] * x[e];
          krmax = fmaxf(krmax, sum8lanes(ss)); }
        { float sr[8], cr[8], sc[8], cc[8];
#pragma unroll
          for (int e = 0; e < 8; ++e) { sincos_hw(prow * f64[e], sr[e], cr[e]); sincos_hw(pcol * f64[e], sc[e], cc[e]); }
#pragma unroll
          for (int h = 0; h < 4; ++h) head_norm_rope(z + 704 + 128 * h, gbq, QB + (size_t)tok * 512 + 128 * h + 8 * sl, sl, sr, cr, sc, cc);
#pragma unroll
          for (int h = 0; h < 2; ++h) head_norm_rope(z + 1216 + 128 * h, gbk, KB + (size_t)tok * 256 + 128 * h + 8 * sl, sl, sr, cr, sc, cc); }
    }
    { const int ln = lane_opaque(); krmax = fmaxf(krmax, shx(krmax, 8, ln)); krmax = fmaxf(krmax, shx(krmax, 16, ln)); krmax = fmaxf(krmax, shx(krmax, 32, ln)); }
    if (lane == 0) atomicMax((unsigned*)(ws + WS_SLOTS) + 64 * layer + 40, __float_as_uint(krmax));
}

#ifndef ATT_SD_MLA
#define ATT_SD_MLA 1
#endif
#ifndef ATT_SD_GQA
#define ATT_SD_GQA 2
#endif
__device__ __forceinline__ void phase_attn(const Params& p, int layer, char* lds, int G, int bid) {
    size_t wz_ = 0; asm volatile("" : "+s"(wz_)); unsigned char* ws = p.ws + wz_;
    const bf16_t* QA = (const bf16_t*)(ws + A_QA); const bf16_t* KVA = (const bf16_t*)(ws + A_KVA); const bf16_t* KR = (const bf16_t*)(ws + A_KR);
    const bf16_t* QB = (const bf16_t*)(ws + A_QB); const bf16_t* KB = (const bf16_t*)(ws + A_KB); const bf16_t* VB = (const bf16_t*)(ws + A_VB);
    bf16_t* O = (bf16_t*)(ws + A_O);
    bool gqa_nomax;
    { int tid_ = threadIdx.x; asm volatile("" : "+v"(tid_)); const int lane = tid_ & 63; const float* gq = p.in[8] + layer * HD; const float* gk = p.in[9] + layer * HD;
      float mq = fmaxf(fabsf(gq[lane]), fabsf(gq[64 + lane])), mk = fmaxf(fabsf(gk[lane]), fabsf(gk[64 + lane]));
#pragma unroll
      for (int o = 1; o < 64; o <<= 1) { mq = fmaxf(mq, shx(mq, o, lane)); mk = fmaxf(mk, shx(mk, o, lane)); }
      const float bound = 16.33f * 1.02f * mq * mk;
      gqa_nomax = __builtin_amdgcn_readfirstlane((int)(bound < 40.f)) != 0; }
    unsigned mla_nomax = 0u;
    { const unsigned* sl_ = (const unsigned*)(ws + WS_SLOTS) + 64 * layer;
      const float kr = __uint_as_float(__hip_atomic_load(sl_ + 40, __ATOMIC_RELAXED, __HIP_MEMORY_SCOPE_AGENT));
#pragma unroll
      for (int h = 0; h < 4; ++h) { float sq = 0.f, sk = kr;
#pragma unroll
          for (int g = 0; g < 6; ++g) sq += __uint_as_float(__hip_atomic_load(sl_ + h * 6 + g, __ATOMIC_RELAXED, __HIP_MEMORY_SCOPE_AGENT));
#pragma unroll
          for (int g = 0; g < 4; ++g) sk += __uint_as_float(__hip_atomic_load(sl_ + 24 + h * 4 + g, __ATOMIC_RELAXED, __HIP_MEMORY_SCOPE_AGENT));
          const float bound = 0.07216878364870323f * 1.4426950408889634f * 1.03f * sqrtf(sq * sk);
          if (bound < 80.f) mla_nomax |= 1u << h; }
      mla_nomax = (unsigned)__builtin_amdgcn_readfirstlane((int)mla_nomax); }
    for (int v = bid; v < 256; v += G) {
        const int xcd = v & 7, slot = v >> 3;
        for (int it = 0; it < 6; ++it) {
            const bool prompt = it < 4; const bool mla = prompt ? (it < 2) : (it == 4);
            int b, h, qb, seq; size_t tok0;
            if (prompt) { b = xcd >> 2; h = xcd & 3; qb = 2 * slot + (it & 1); seq = S_PROMPT; tok0 = (size_t)b * S_PROMPT; }
            else { const int combo = 2 * xcd + (slot >> 4); b = combo >> 2; h = combo & 3; qb = slot & 15; seq = S_SAMPLE; tok0 = (size_t)T_PROMPT + (size_t)b * S_SAMPLE; }
            const size_t i0 = tok0 + (size_t)qb * 256;
#ifndef NO_MLA
            if (mla) { if ((mla_nomax >> h) & 1u) att::attn_body<192, QA_W, KVA_W, KVA_W, DM, ATT_SD_MLA, true>(QA + i0 * QA_W + h * 192, KVA + tok0 * KVA_W + h * 256, KR + tok0 * ROPE, KVA + tok0 * KVA_W + h * 256 + 128,
                                                                    O + i0 * DM + h * 128, seq, qb * 256, lds);
                       else att::attn_body<192, QA_W, KVA_W, KVA_W, DM, ATT_SD_MLA, false>(QA + i0 * QA_W + h * 192, KVA + tok0 * KVA_W + h * 256, KR + tok0 * ROPE, KVA + tok0 * KVA_W + h * 256 + 128,
                                                                    O + i0 * DM + h * 128, seq, qb * 256, lds); }
#endif
#ifndef NO_GQA
            if (!mla) { if (gqa_nomax) att::attn_body<128, 512, 256, 256, DM, 1, true>(QB + i0 * 512 + h * 128, KB + tok0 * 256 + (h >> 1) * 128, nullptr, VB + tok0 * 256 + (h >> 1) * 128,
                                                                O + i0 * DM + 512 + h * 128, seq, qb * 256, lds);
                        else att::attn_body<128, 512, 256, 256, DM, ATT_SD_GQA, false>(QB + i0 * 512 + h * 128, KB + tok0 * 256 + (h >> 1) * 128, nullptr, VB + tok0 * 256 + (h >> 1) * 128,
                                                                O + i0 * DM + 512 + h * 128, seq, qb * 256, lds); }
#endif
        }
    }
}

constexpr int PH_PER_LAYER = 9, N_PHASES = DEPTH * PH_PER_LAYER + 1;

__global__ void __launch_bounds__(NWAVES * 64, 2) hymba_fwd(Params p) {
    extern __shared__ __attribute__((aligned(16))) unsigned char lds_raw[];
    LAS unsigned char* lds = (LAS unsigned char*)lds_raw;
    const int G = gridDim.x, bid = blockIdx.x, NGW = G * NWAVES;
#define FRESH() int tid_ = threadIdx.x; asm volatile("" : "+v"(tid_)); const int lane = tid_ & 63, wave = __builtin_amdgcn_readfirstlane(tid_ >> 6), gw = bid * NWAVES + wave; (void)lane; (void)gw
    const int lo = p.ph_lo, hi = p.ph_hi;
#define WSP() size_t wz_ = 0; asm volatile("" : "+s"(wz_)); unsigned char* ws = p.ws + wz_
#if MK_PER_PHASE
#define GRID_SYNC() do {} while (0)
#else
    cg::grid_group grid = cg::this_grid();
    volatile LAS unsigned* xbst = (volatile LAS unsigned*)(lds + LDS_XB);
    if (threadIdx.x < 4) xbst[threadIdx.x] = 0u;
    __syncthreads();
    XcdBarrier xbar = xcd_barrier_post((unsigned*)(p.ws + WS_BAR), xbst);
    bool first_sync = true;
#define GRID_SYNC() do { if (first_sync) { grid.sync(); first_sync = false; } else xcd_barrier(xbar); } while (0)
#endif
#ifdef TESTPH
#define IN(k) ((k) == TESTPH)
#else
#define IN(k) (lo <= (k) && (k) < hi)
#endif
#define SEAM(k) do { if (IN((k) + 1)) GRID_SYNC(); } while (0)
    const float* x_prompt = p.in[0]; const float* x_sample = p.in[1];
    float* X = p.out;


#ifdef TESTPH
#pragma unroll
#endif
    for (int layer = 0; layer < DEPTH; ++layer) {
        const int pb = layer * PH_PER_LAYER;
        if (IN(pb + 0)) {
            FRESH(); WSP();
            for (int rep = 0; rep < REP_THIN; ++rep) {
#ifndef NO_WT
            phase_weights(p, layer, lds, gw, NGW, wave, lane);
#endif
            if (layer == 0) phase_norm(x_prompt, x_sample, p.in[2] + layer * DM, (bf16_t*)(ws + A_H), gw, NGW, lane);
            else phase_norm_b16((const bf16_t*)X, p.in[2] + layer * DM, (bf16_t*)(ws + A_H), gw, NGW, lane);
            __syncthreads();
            }
            SEAM(pb + 0);
        }
        if (IN(pb + 1)) {
            WSP();
            pg8::Gemm g{(const bf16_t*)(ws + A_H), (const bf16_t*)(ws + W_IN), T, INW_PAD, DM}; pg8::StaticOrder S; S.init(T, INW_PAD, G, bid);
            pg8::EpiZ E{(bf16_t*)(ws + A_Z), (bf16_t*)(ws + A_VB), nullptr};
#ifndef NO_GEMM
            pg8::gemm_phase(lds, g, S, E);
#endif
            SEAM(pb + 1);
        }
        if (IN(pb + 2)) {
            FRESH();
#ifndef NO_POST
            for (int rep = 0; rep < REP_THIN; ++rep) phase_post(p, layer, gw, NGW, lane);
#endif
            SEAM(pb + 2); }
        if (IN(pb + 3)) {
            WSP();
            { pg8::Gemm g{(const bf16_t*)(ws + A_CQN), (const bf16_t*)(ws + W_Q), T, QA_W, QLORA}; pg8::StaticOrder S; S.init(T, QA_W, G, bid);
              pg8::EpiBf16Norm E{(bf16_t*)(ws + A_QA), QA_W, (unsigned*)(ws + WS_SLOTS) + 64 * layer, 0};
#ifndef NO_GEMM
              pg8::gemm_phase(lds, g, S, E);
#endif
            }
            { pg8::Gemm g{(const bf16_t*)(ws + A_CKVN), (const bf16_t*)(ws + W_KV), T, KVA_W, KVLORA}; pg8::StaticOrder S; S.init(T, KVA_W, G, bid);
              pg8::EpiBf16Norm E{(bf16_t*)(ws + A_KVA), KVA_W, (unsigned*)(ws + WS_SLOTS) + 64 * layer, 1};
#ifndef NO_GEMM
              pg8::gemm_phase(lds, g, S, E);
#endif
            }
            SEAM(pb + 3);
        }
        if (IN(pb + 4)) {
#ifndef NO_ATTN
            for (int rep = 0; rep < REP_ATTN; ++rep) phase_attn(p, layer, (char*)lds_raw, G, bid);
#endif
            SEAM(pb + 4); }
        if (IN(pb + 5)) {
            WSP();
            pg8::Gemm g{(const bf16_t*)(ws + A_O), (const bf16_t*)(ws + W_O), T, DM, DM}; pg8::StaticOrder S; S.init(T, DM, G, bid);
            if (layer == 0) { pg8::EpiResB16<true> E{(bf16_t*)X, x_prompt, x_sample, T_PROMPT, DM, nullptr, (float*)(ws + WS_RS)}; pg8::gemm_phase(lds, g, S, E); }
            else { pg8::EpiResB16<false> E{(bf16_t*)X, X, nullptr, 0, DM, nullptr, (float*)(ws + WS_RS)}; pg8::gemm_phase(lds, g, S, E); }
            SEAM(pb + 5);
        }
        if (IN(pb + 7)) {
            WSP();
            pg8::Gemm g{(const bf16_t*)X, (const bf16_t*)(ws + W_UP), T, DFF, DM}; pg8::StaticOrder S; S.init(T, DFF, G, bid);
            pg8::EpiBf16<1> E{(bf16_t*)(ws + A_U), DFF, nullptr};
#ifndef NO_GEMM
            pg8::gemm_phase(lds, g, S, E);
#endif
            SEAM(pb + 7);
        }
        if (IN(pb + 8)) {
            WSP();
            pg8::Gemm g{(const bf16_t*)(ws + A_U), (const bf16_t*)(ws + W_DN), T, DM, DFF}; pg8::StaticOrder S; S.init(T, DM, G, bid);
            pg8::EpiResB16<false> E{layer == DEPTH - 1 ? (bf16_t*)(ws + A_H2) : (bf16_t*)X, X, nullptr, 0, DM, (const float*)(ws + WS_RS), nullptr};
#ifndef NO_GEMM
            pg8::gemm_phase(lds, g, S, E);
#endif
            SEAM(pb + 8);
        }
    }
    if (IN(N_PHASES - 1)) { FRESH(); WSP(); phase_final_norm_b16((const bf16_t*)(ws + A_H2), X, p.in[14], gw, NGW, lane); }
#undef IN
#undef SEAM
#undef GRID_SYNC
}

extern "C" void kernel_launch(void* const* d_in, const int* in_sizes, int n_in, void* d_out, int out_size, void* d_ws, size_t ws_size, hipStream_t stream) {
    static int grid = 0;
    if (grid == 0) {
        if (n_in != 15 || out_size != T * DM || ws_size < WS_TOTAL) {
            fprintf(stderr, "kernel_launch: shape mismatch: n_in %d out %d ws %zu (need %zu)\n", n_in, out_size, ws_size, (size_t)WS_TOTAL); grid = -1; return; }
        int dev = 0, cus = 0, per_cu = 0;
        if (hipGetDevice(&dev) != hipSuccess || hipDeviceGetAttribute(&cus, hipDeviceAttributeMultiprocessorCount, dev) != hipSuccess) { fprintf(stderr, "kernel_launch: device query failed\n"); grid = -1; return; }
        if (hipFuncSetAttribute((const void*)hymba_fwd, hipFuncAttributeMaxDynamicSharedMemorySize, LDS_BYTES) != hipSuccess) { fprintf(stderr, "kernel_launch: hipFuncSetAttribute failed\n"); grid = -1; return; }
        if (hipOccupancyMaxActiveBlocksPerMultiprocessor(&per_cu, (const void*)hymba_fwd, NWAVES * 64, LDS_BYTES) != hipSuccess || per_cu < 1) {
            fprintf(stderr, "kernel_launch: occupancy query reports %d workgroups per CU\n", per_cu); per_cu = 1; }
        (void)hipGetLastError();
        grid = cus;
        if (grid > 256) grid = 256;
    }
    if (grid < 0) return;
    Params p{};
    for (int i = 0; i < 15; ++i) p.in[i] = (const float*)d_in[i];
    p.out = (float*)d_out; p.ws = (unsigned char*)d_ws;
#if !MK_PER_PHASE
    if (hipMemsetAsync((char*)d_ws + WS_BAR, 0, 16384, stream) != hipSuccess) { fprintf(stderr, "kernel_launch: memset of the barrier words failed\n"); return; }
#endif
#if MK_PER_PHASE
    for (int ph = 0; ph < N_PHASES; ++ph) {
        p.ph_lo = ph; p.ph_hi = ph + 1;
        hipLaunchKernelGGL(hymba_fwd, dim3(grid), dim3(NWAVES * 64), LDS_BYTES, stream, p);
    }
#else
    p.ph_lo = 0; p.ph_hi = N_PHASES;
    void* args[] = {&p};
    hipError_t e = hipLaunchCooperativeKernel((const void*)hymba_fwd, dim3(grid), dim3(NWAVES * 64), args, LDS_BYTES, stream);
    if (e != hipSuccess) fprintf(stderr, "kernel_launch: cooperative launch failed: %s (grid %d)\n", hipGetErrorString(e), grid);
#endif
}
```

```cpp
#include <hip/hip_runtime.h>
#include <hip/hip_cooperative_groups.h>
#include <cstdio>
#include <cstdint>
namespace cg = cooperative_groups;

#ifndef MK_PER_PHASE
#define MK_PER_PHASE 0
#endif

#ifndef REP_ATTN
#define REP_ATTN 1
#endif
#ifndef REP_THIN
#define REP_THIN 1
#endif
#define LAS __attribute__((address_space(3)))
#define GAS __attribute__((address_space(1)))
typedef unsigned short bf16_t;
typedef short bf16x8 __attribute__((ext_vector_type(8)));
typedef short s16x4 __attribute__((ext_vector_type(4)));
typedef float f32x4 __attribute__((ext_vector_type(4)));
typedef float f32x16 __attribute__((ext_vector_type(16)));
typedef unsigned u32x4 __attribute__((ext_vector_type(4)));
typedef unsigned u32x2 __attribute__((ext_vector_type(2)));

constexpr int DM = 1024, T_PROMPT = 2 * 16384, T_SAMPLE = 4 * 4096, T = T_PROMPT + T_SAMPLE;
constexpr int S_PROMPT = 16384, S_SAMPLE = 4096;
constexpr int DEPTH = 2;
constexpr int QLORA = 384, KVLORA = 256, NOPE = 128, ROPE = 64, VD = 128, HD = 128;
constexpr int INW = 1728, INW_PAD = 1792, DFF = 4096;
constexpr int QA_W = 4 * (NOPE + ROPE)  , KVA_W = 4 * (NOPE + VD)  ;
constexpr float EPS = 1e-6f;
constexpr float LOG2_THETA = 13.287712379549449f;
constexpr float INV_2PI = 0.15915494309189535f;

constexpr size_t W_IN = 0, W_Q = W_IN + (size_t)INW_PAD * DM * 2, W_KV = W_Q + (size_t)QA_W * QLORA * 2, W_O = W_KV + (size_t)KVA_W * KVLORA * 2,
                 W_UP = W_O + (size_t)DM * DM * 2, W_DN = W_UP + (size_t)DFF * DM * 2, W_END = W_DN + (size_t)DM * DFF * 2;
constexpr size_t AR = (W_END + 255) / 256 * 256;
constexpr size_t A_Z = AR, A_QA = A_Z, A_KVA = A_QA + (size_t)T * QA_W * 2;
constexpr size_t A_O = A_Z + (size_t)T * INW_PAD * 2, A_H = A_O;
constexpr size_t A_CQN = A_O + (size_t)T * DM * 2, A_CKVN = A_CQN + (size_t)T * QLORA * 2, A_KR = A_CKVN + (size_t)T * KVLORA * 2,
                 A_QB = A_KR + (size_t)T * ROPE * 2, A_KB = A_QB + (size_t)T * 512 * 2, A_VB = A_KB + (size_t)T * 256 * 2, A_END1 = A_VB + (size_t)T * 256 * 2;
constexpr size_t A_H2 = AR, A_U = A_H2 + (size_t)T * DM * 2, A_END2 = A_U + (size_t)T * DFF * 2;
constexpr size_t WS_NEED = A_END1 > A_END2 ? A_END1 : A_END2;
static_assert(A_KVA + (size_t)T * KVA_W * 2 == A_O, "QA|KVA must overlay Z exactly");

constexpr int LDS_XB = 131072;
constexpr int LDS_BYTES = 131072 + 16;
constexpr size_t WS_BAR = (WS_NEED + 255) / 256 * 256, WS_RS = WS_BAR + 16384, WS_TOTAL = WS_RS + (size_t)T * 16 * 4;
constexpr size_t WS_SLOTS = WS_BAR + 3456 * 4;
constexpr int NWAVES = 8;

__device__ __forceinline__ unsigned cvt_pk_bf16(float lo, float hi) { unsigned r; asm volatile("v_cvt_pk_bf16_f32 %0, %1, %2" : "=v"(r) : "v"(lo), "v"(hi)); return r; }
__device__ __forceinline__ bf16_t f2bf(float f) { unsigned u = __float_as_uint(f); u += 0x7FFFu + ((u >> 16) & 1u); return (bf16_t)(u >> 16); }
__device__ __forceinline__ float bf2f(bf16_t b) { return __uint_as_float(((unsigned)b) << 16); }
__device__ __forceinline__ int lane_opaque() { unsigned z = 0u; asm volatile("" : "+v"(z)); return (int)__builtin_amdgcn_mbcnt_hi(~0u, __builtin_amdgcn_mbcnt_lo(~0u, z)); }
__device__ __forceinline__ float shx(float v, int o, int l) { return __int_as_float(__builtin_amdgcn_ds_bpermute((l ^ o) << 2, __float_as_int(v))); }
__device__ __forceinline__ float wave_sum(float v) {
    const int l = lane_opaque();
#pragma unroll
    for (int o = 1; o < 64; o <<= 1) v += shx(v, o, l);
    return v;
}
__device__ __forceinline__ int seq_pos(int tok) { return tok < T_PROMPT ? (tok & (S_PROMPT - 1)) : (tok & (S_SAMPLE - 1)); }
__device__ __forceinline__ void sincos_hw(float ang, float& s, float& c) { const float r = ang * INV_2PI; s = __builtin_amdgcn_sinf(r); c = __builtin_amdgcn_cosf(r); }

namespace pg8 {
constexpr int BM = 256, BK = 64, HALF = 128, HTB = HALF * BK * 2, STAGE_BYTES = 8 * HTB, NXCD = 8, WGM = 8;
__host__ __device__ __forceinline__ int lds_byte(int r, int c) { const int st = (r >> 4) * 2 + (c >> 5), rr = r & 15, cc = c & 31, ob = rr * 64 + cc * 2; return st * 1024 + (ob ^ (((ob >> 9) & 1) << 5)); }
__host__ __device__ __forceinline__ void stage_rc(int b, int& R, int& C) { const int st = b / 1024, sb = b % 1024, swz = sb ^ (((sb >> 9) & 1) << 5); R = (st >> 1) * 16 + swz / 64; C = (st & 1) * 32 + (swz % 64) / 2; }
__host__ __device__ __forceinline__ int perm32(int rho) { const int n = rho >> 4, i = rho & 15; return 8 * (i >> 2) + 4 * n + (i & 3); }
struct Unit { int pm, pn; };
struct Gemm { const bf16_t* A; const bf16_t* Bt; int M, N, K; };
struct StaticOrder {
    int nM, nN, nwg, G, c;
    __device__ void init(int M, int N, int G_, int c_) { nM = M / BM; nN = N / BM; nwg = nM * nN; G = G_; c = c_; }
    __device__ bool next(int i, Unit& u) const {
        const long L = (long)i * G + c; if (L >= nwg) return false;
        int wgid = (int)L; { const int q = nwg / NXCD, r = nwg % NXCD, xcd = wgid % NXCD, off = wgid / NXCD; wgid = (xcd < r ? xcd * (q + 1) : r * (q + 1) + (xcd - r) * q) + off; }
        const int nig = WGM * nN, gid = wgid / nig, fm = gid * WGM, gsz = (nM - fm) < WGM ? (nM - fm) : WGM;
        u.pm = fm + ((wgid % nig) % gsz); u.pn = (wgid % nig) / gsz; return true;
    }
};
template <int ACT  > struct EpiBf16 {
    static constexpr bool PERM = true;
    bf16_t* O; int ldc; const float* rs;
    __device__ __forceinline__ void operator()(const f32x4 (&acc)[2][2][4][2], const Unit& u, int wr, int wc, int fr, int fq) const {
        const int row0 = u.pm * BM + wr * 64 + fr, col0 = u.pn * BM + wc * 32 + 8 * fq;
#pragma unroll
        for (int ai = 0; ai < 2; ++ai)
#pragma unroll
            for (int m = 0; m < 4; ++m) { bf16_t* rowp = O + (size_t)(row0 + ai * HALF + m * 16) * ldc + col0;
                const float sc = rs ? rs[row0 + ai * HALF + m * 16] : 1.f;
#pragma unroll
                for (int bj = 0; bj < 2; ++bj) { f32x4 v0 = acc[ai][bj][m][0] * sc, v1 = acc[ai][bj][m][1] * sc;
                    if (ACT == 1) {
#pragma unroll
                        for (int j = 0; j < 4; ++j) { const float a = fmaxf(v0[j], 0.f), b = fmaxf(v1[j], 0.f); v0[j] = a * a; v1[j] = b * b; } }
                    u32x4 w; w.x = cvt_pk_bf16(v0[0], v0[1]); w.y = cvt_pk_bf16(v0[2], v0[3]); w.z = cvt_pk_bf16(v1[0], v1[1]); w.w = cvt_pk_bf16(v1[2], v1[3]);
                    *(u32x4*)(rowp + bj * HALF) = w; } }
    }
};
struct EpiZ {
    static constexpr bool PERM = true;
    bf16_t* Z; bf16_t* VB; const float* rs;
    __device__ __forceinline__ void operator()(const f32x4 (&acc)[2][2][4][2], const Unit& u, int wr, int wc, int fr, int fq) const {
        const int row0 = u.pm * BM + wr * 64 + fr;
#pragma unroll
        for (int bj = 0; bj < 2; ++bj) {
            const int g0 = u.pn * BM + bj * HALF + wc * 32;
            const bool tovb = g0 >= 1472;
            bf16_t* base = tovb ? VB + (g0 - 1472) + 8 * fq : Z + g0 + 8 * fq; const int ld = tovb ? 256 : INW_PAD;
            if (g0 < INW) {
#pragma unroll
                for (int ai = 0; ai < 2; ++ai)
#pragma unroll
                    for (int m = 0; m < 4; ++m) { const float sc = rs ? rs[row0 + ai * HALF + m * 16] : 1.f; const f32x4 v0 = acc[ai][bj][m][0] * sc, v1 = acc[ai][bj][m][1] * sc;
                        u32x4 w; w.x = cvt_pk_bf16(v0[0], v0[1]); w.y = cvt_pk_bf16(v0[2], v0[3]); w.z = cvt_pk_bf16(v1[0], v1[1]); w.w = cvt_pk_bf16(v1[2], v1[3]);
                        *(u32x4*)(base + (size_t)(row0 + ai * HALF + m * 16) * ld) = w; } }
        }
    }
};
struct EpiBf16Norm {
    static constexpr bool PERM = true;
    bf16_t* O; int ldc; unsigned* slots; int mode;
    __device__ __forceinline__ void operator()(const f32x4 (&acc)[2][2][4][2], const Unit& u, int wr, int wc, int fr, int fq) const {
        const int row0 = u.pm * BM + wr * 64 + fr, col0 = u.pn * BM + wc * 32 + 8 * fq; const int ln = lane_opaque();
#pragma unroll
        for (int bj = 0; bj < 2; ++bj) {
            float mx = 0.f;
#pragma unroll
            for (int ai = 0; ai < 2; ++ai)
#pragma unroll
                for (int m = 0; m < 4; ++m) { const f32x4 v0 = acc[ai][bj][m][0], v1 = acc[ai][bj][m][1];
                    float ss = (v0[0] * v0[0] + v0[1] * v0[1]) + (v0[2] * v0[2] + v0[3] * v0[3]) + (v1[0] * v1[0] + v1[1] * v1[1]) + (v1[2] * v1[2] + v1[3] * v1[3]);
                    ss += shx(ss, 16, ln); ss += shx(ss, 32, ln); mx = fmaxf(mx, ss);
                    u32x4 w; w.x = cvt_pk_bf16(v0[0], v0[1]); w.y = cvt_pk_bf16(v0[2], v0[3]); w.z = cvt_pk_bf16(v1[0], v1[1]); w.w = cvt_pk_bf16(v1[2], v1[3]);
                    *(u32x4*)(O + (size_t)(row0 + ai * HALF + m * 16) * ldc + col0 + bj * HALF) = w; }
#pragma unroll
            for (int o = 1; o < 16; o <<= 1) mx = fmaxf(mx, shx(mx, o, ln));
            const int g0 = u.pn * BM + bj * HALF + wc * 32;
            const int slot = mode == 0 ? (g0 / 192) * 6 + (g0 % 192) / 32 : 24 + u.pn * 4 + wc;
            if (fr == 0 && fq == 0 && (mode == 0 || bj == 0)) atomicMax(slots + slot, __float_as_uint(mx));
        }
    }
};
template <bool RES_F32> struct EpiResB16 {
    static constexpr bool PERM = true;
    bf16_t* out; const void* res_lo; const void* res_hi; int split; int ldc;
    const float* st_in;
    float* st_out;
    __device__ __forceinline__ void operator()(const f32x4 (&acc)[2][2][4][2], const Unit& u, int wr, int wc, int fr, int fq) const {
        const int row0 = u.pm * BM + wr * 64 + fr, col0 = u.pn * BM + wc * 32 + 8 * fq;
#pragma unroll
        for (int ai = 0; ai < 2; ++ai)
#pragma unroll
            for (int m = 0; m < 4; ++m) { const int row = row0 + ai * HALF + m * 16; float sc = 1.f;
                if (st_in) { const f32x4* sp = (const f32x4*)(st_in + (size_t)row * 16); const f32x4 a = sp[0], b = sp[1], c = sp[2], d = sp[3];
                    const float ssum = ((a[0] + a[1]) + (a[2] + a[3])) + ((b[0] + b[1]) + (b[2] + b[3])) + ((c[0] + c[1]) + (c[2] + c[3])) + ((d[0] + d[1]) + (d[2] + d[3]));
                    sc = 1.f / (ssum * (1.f / 1024.f) + 1e-6f); }
                float ssq = 0.f;
#pragma unroll
                for (int bj = 0; bj < 2; ++bj) { f32x4 v0 = acc[ai][bj][m][0] * sc, v1 = acc[ai][bj][m][1] * sc;
                    if constexpr (RES_F32) { const float* rp = (row < split ? (const float*)res_lo + (size_t)row * ldc : (const float*)res_hi + (size_t)(row - split) * ldc) + col0 + bj * HALF;
                        v0 += *(const f32x4*)rp; v1 += *(const f32x4*)(rp + 4); }
                    else { const u32x4 r = *(const u32x4*)((const bf16_t*)res_lo + (size_t)row * ldc + col0 + bj * HALF);
                        v0[0] += __uint_as_float(r.x << 16); v0[1] += __uint_as_float(r.x & 0xffff0000u); v0[2] += __uint_as_float(r.y << 16); v0[3] += __uint_as_float(r.y & 0xffff0000u);
                        v1[0] += __uint_as_float(r.z << 16); v1[1] += __uint_as_float(r.z & 0xffff0000u); v1[2] += __uint_as_float(r.w << 16); v1[3] += __uint_as_float(r.w & 0xffff0000u); }
                    u32x4 w; w.x = cvt_pk_bf16(v0[0], v0[1]); w.y = cvt_pk_bf16(v0[2], v0[3]); w.z = cvt_pk_bf16(v1[0], v1[1]); w.w = cvt_pk_bf16(v1[2], v1[3]);
                    *(u32x4*)(out + (size_t)row * ldc + col0 + bj * HALF) = w;
                    ssq += ((v0[0] * v0[0] + v0[1] * v0[1]) + (v0[2] * v0[2] + v0[3] * v0[3])) + ((v1[0] * v1[0] + v1[1] * v1[1]) + (v1[2] * v1[2] + v1[3] * v1[3])); }
                if (st_out) { const int ln = lane_opaque(); ssq += shx(ssq, 16, ln); ssq += shx(ssq, 32, ln);
                    if (fq == 0) st_out[(size_t)row * 16 + u.pn * 4 + wc] = ssq; } }
    }
};
struct EpiResF32 {
    static constexpr bool PERM = false;
    float* C; const float* res_lo; const float* res_hi; int split; int ldc;
    __device__ __forceinline__ void operator()(const f32x4 (&acc)[2][2][4][2], const Unit& u, int wr, int wc, int fr, int fq) const {
        const int row0 = u.pm * BM + wr * 64 + fr, col0 = u.pn * BM + wc * 32 + 4 * fq;
#pragma unroll
        for (int ai = 0; ai < 2; ++ai)
#pragma unroll
            for (int m = 0; m < 4; ++m) { const int row = row0 + ai * HALF + m * 16;
                const float* rp = (row < split ? res_lo + (size_t)row * ldc : res_hi + (size_t)(row - split) * ldc) + col0;
                float* rowp = C + (size_t)row * ldc + col0;
#pragma unroll
                for (int bj = 0; bj < 2; ++bj)
#pragma unroll
                    for (int n = 0; n < 2; ++n) { const f32x4 r = *(const f32x4*)(rp + bj * HALF + n * 16); *(f32x4*)(rowp + bj * HALF + n * 16) = acc[ai][bj][m][n] + r; } }
    }
};
template <class Epi, class Sched>
__device__ __forceinline__ void gemm_phase(LAS unsigned char* lds, const Gemm g, const Sched& S, const Epi& E) {
    int tid_ = threadIdx.x; asm volatile("" : "+v"(tid_));
    const int tid = tid_, wid = __builtin_amdgcn_readfirstlane(tid >> 6), lane = tid & 63, wr = wid >> 2, wc = wid & 3, fr = lane & 15, fq = lane >> 4;
    const int K = g.K, nt = K / BK;
    unsigned voffA[2], voffB[2];
#pragma unroll
    for (int i = 0; i < 2; ++i) { int R, C; stage_rc(tid * 16 + i * 8192, R, C); const int Rb = Epi::PERM ? ((R & ~31) + perm32(R & 31)) : R;
        voffA[i] = (unsigned)(R * K + C) * 2u; voffB[i] = (unsigned)(Rb * K + C) * 2u; }
    const size_t kstep = (size_t)(BK * 2);
    const size_t hstep = (size_t)HALF * K * 2;
    const size_t tstep = 2 * hstep;
    const unsigned ldsw = (unsigned)wid * 1024u;
    const int aoff = lds_byte(wr * 64 + fr, fq * 8), boff = lds_byte(wc * 32 + fr, fq * 8);
#define PG8_SA(b, h) (((b) * 2 + (h)) * HTB)
#define PG8_SB(b, h) ((4 + (b) * 2 + (h)) * HTB)
#define PG8_STAGE(bufoff, gbase, voff) do { _Pragma("unroll") for (int _i = 0; _i < 2; ++_i) \
        __builtin_amdgcn_global_load_lds((const unsigned*)((const char*)(gbase) + (voff)[_i]), (LAS unsigned*)(lds + (bufoff) + ldsw + _i * 8192), 16, 0, 0); } while (0)
#define PG8_LDA(dst, b, h) do { _Pragma("unroll") for (int m = 0; m < 4; ++m) _Pragma("unroll") for (int k = 0; k < 2; ++k) dst[m][k] = *(const LAS bf16x8*)(lds + PG8_SA(b, h) + aoff + m * 2048 + k * 1024); } while (0)
#define PG8_LDB(dst, b, h) do { _Pragma("unroll") for (int n = 0; n < 2; ++n) _Pragma("unroll") for (int k = 0; k < 2; ++k) dst[n][k] = *(const LAS bf16x8*)(lds + PG8_SB(b, h) + boff + n * 2048 + k * 1024); } while (0)
#define PG8_MMA(ai, bj, At, Bt) do { __builtin_amdgcn_s_setprio(1); _Pragma("unroll") for (int m = 0; m < 4; ++m) _Pragma("unroll") for (int n = 0; n < 2; ++n) _Pragma("unroll") for (int k = 0; k < 2; ++k) \
        acc[ai][bj][m][n] = __builtin_amdgcn_mfma_f32_16x16x32_bf16(Bt[n][k], At[m][k], acc[ai][bj][m][n], 0, 0, 0); __builtin_amdgcn_s_setprio(0); } while (0)
#define PG8_WAIT_V(n) asm volatile("s_waitcnt vmcnt(" #n ")" ::: "memory")
#define PG8_WAIT_L(n) asm volatile("s_waitcnt lgkmcnt(" #n ")" ::: "memory")
#define PG8_BAR __builtin_amdgcn_s_barrier()
#define PG8_SCHED __builtin_amdgcn_sched_barrier(0)
    Unit cur, nxt; int ui = 0;
    if (!S.next(0, cur)) return;
    f32x4 acc[2][2][4][2];
#pragma unroll
    for (int a = 0; a < 2; ++a)
#pragma unroll
        for (int b = 0; b < 2; ++b)
#pragma unroll
            for (int m = 0; m < 4; ++m)
#pragma unroll
                for (int n = 0; n < 2; ++n) acc[a][b][m][n] = (f32x4){0.f, 0.f, 0.f, 0.f};
    bf16x8 At[4][2], B0[2][2], B1[2][2];
    const char* cA = (const char*)g.A + (size_t)cur.pm * tstep; const char* cB = (const char*)g.Bt + (size_t)cur.pn * tstep;
    PG8_STAGE(PG8_SB(0, 0), cB, voffB); PG8_STAGE(PG8_SB(0, 1), cB + hstep, voffB); PG8_STAGE(PG8_SA(0, 0), cA, voffA); PG8_STAGE(PG8_SA(0, 1), cA + hstep, voffA);
    if (wr == 1) PG8_BAR;
    PG8_WAIT_V(2); PG8_BAR;
    PG8_STAGE(PG8_SB(1, 0), cB + kstep, voffB); PG8_STAGE(PG8_SA(1, 0), cA + kstep, voffA); PG8_STAGE(PG8_SB(1, 1), cB + hstep + kstep, voffB);
    PG8_WAIT_V(6); PG8_BAR;
    for (;;) {
        const bool has_next = S.next(ui + 1, nxt);
        const char* nA = has_next ? (const char*)g.A + (size_t)nxt.pm * tstep : cA; const char* nB = has_next ? (const char*)g.Bt + (size_t)nxt.pn * tstep : cB;
        for (int t = 0; t < nt; t += 2) {
            const bool last = (t == nt - 2);
            const char* a1 = cA + (size_t)(t + 1) * kstep;
            const char* a2 = last ? nA : cA + (size_t)(t + 2) * kstep; const char* b2 = last ? nB : cB + (size_t)(t + 2) * kstep;
            const char* a3 = a2 + kstep; const char* b3 = b2 + kstep;
            PG8_LDB(B0, 0, 0); PG8_LDB(B1, 0, 1); PG8_SCHED; PG8_LDA(At, 0, 0); PG8_STAGE(PG8_SA(1, 1), a1 + hstep, voffA);
            PG8_WAIT_V(8); PG8_WAIT_L(0); PG8_BAR; PG8_MMA(0, 0, At, B0); PG8_MMA(0, 1, At, B1); PG8_BAR; PG8_SCHED;
            PG8_LDA(At, 0, 1); PG8_STAGE(PG8_SB(0, 0), b2, voffB); PG8_STAGE(PG8_SB(0, 1), b2 + hstep, voffB); PG8_STAGE(PG8_SA(0, 0), a2, voffA);
            PG8_WAIT_V(8); PG8_WAIT_L(0); PG8_BAR; PG8_MMA(1, 0, At, B0); PG8_MMA(1, 1, At, B1); PG8_BAR; PG8_SCHED;
            PG8_LDB(B0, 1, 0); PG8_LDB(B1, 1, 1); PG8_SCHED; PG8_LDA(At, 1, 0); PG8_STAGE(PG8_SA(0, 1), a2 + hstep, voffA);
            PG8_WAIT_V(8); PG8_WAIT_L(0); PG8_BAR; PG8_MMA(0, 0, At, B0); PG8_MMA(0, 1, At, B1); PG8_BAR; PG8_SCHED;
            PG8_LDA(At, 1, 1); PG8_STAGE(PG8_SB(1, 0), b3, voffB); PG8_STAGE(PG8_SB(1, 1), b3 + hstep, voffB); PG8_STAGE(PG8_SA(1, 0), a3, voffA);
            PG8_WAIT_V(8); PG8_WAIT_L(0); PG8_BAR; PG8_MMA(1, 0, At, B0); PG8_MMA(1, 1, At, B1); PG8_BAR; PG8_SCHED;
        }
        if (wr == 0) PG8_BAR;
        E(acc, cur, wr, wc, fr, fq);
        if (!has_next) break;
#pragma unroll
        for (int a = 0; a < 2; ++a)
#pragma unroll
            for (int b = 0; b < 2; ++b)
#pragma unroll
                for (int m = 0; m < 4; ++m)
#pragma unroll
                    for (int n = 0; n < 2; ++n) acc[a][b][m][n] = (f32x4){0.f, 0.f, 0.f, 0.f};
        cur = nxt; cA = nA; cB = nB; ++ui;
        if (wr == 1) PG8_BAR;
    }
    PG8_WAIT_V(0);
    PG8_BAR;
#undef PG8_SA
#undef PG8_SB
#undef PG8_STAGE
#undef PG8_LDA
#undef PG8_LDB
#undef PG8_MMA
#undef PG8_WAIT_V
#undef PG8_WAIT_L
#undef PG8_BAR
#undef PG8_SCHED
}
}

namespace att {
constexpr int NW = 8, QBLK = 32, KVBLK = 64;
constexpr float THR = 8.f;
#define SBAR() __builtin_amdgcn_sched_barrier(0)
__device__ __forceinline__ int crow(int r, int hi) { return (r & 3) + 8 * (r >> 2) + 4 * hi; }

template <int DQK> struct Cfg {
    static constexpr float SCALE = DQK == 192 ? 0.07216878364870323f : 0.08838834764831845f;
    static constexpr int KROW = DQK * 2;
    static constexpr size_t SHM_V = KVBLK * 128 * 2, SHM_K = (size_t)KVBLK * DQK * 2;
    static constexpr size_t SHM_TOTAL = 2 * SHM_V + 2 * SHM_K + NW * 64 * 4;
};
template <int DQK> __device__ __forceinline__ int kswz(int row, int colB) {
    if constexpr (DQK == 128) return row * 256 + (colB ^ ((row & 15) << 4));
    else return row * (DQK * 2) + (colB ^ (((row >> 1) & 7) << 4));
}

constexpr float THRL = THR * 1.4426950408889634f;
template <int MODE>
__device__ __forceinline__ void partialSM(f32x16& p0, f32x16& p1, float& m_reg, float& alpha) {
    constexpr bool FIRST = MODE == 1;
    if constexpr (MODE == 2) { alpha = 1.f;
#pragma unroll
        for (int r = 0; r < 16; ++r) p0[r] = __builtin_amdgcn_exp2f(p0[r]);
        return; }
    float pmax = p0[0];
#pragma unroll
    for (int r = 1; r < 16; ++r) pmax = fmaxf(pmax, p0[r]);
#pragma unroll
    for (int r = 0; r < 16; ++r) pmax = fmaxf(pmax, p1[r]);
    { auto rr = __builtin_amdgcn_permlane32_swap(__float_as_uint(pmax), __float_as_uint(pmax), false, false);
      pmax = fmaxf(__uint_as_float(rr[0]), __uint_as_float(rr[1])); }
    if constexpr (FIRST) {
        m_reg = pmax; alpha = 1.f;
#pragma unroll
        for (int r = 0; r < 16; ++r) { p0[r] -= pmax; p1[r] -= pmax; }
    } else {
        if (__builtin_expect(__all(pmax <= THRL), 1)) { alpha = 1.f; }
        else { const float d = fmaxf(pmax, 0.f); alpha = __builtin_amdgcn_exp2f(-d); m_reg += d;
#pragma unroll
            for (int r = 0; r < 16; ++r) { p0[r] -= d; p1[r] -= d; } }
    }
#pragma unroll
    for (int r = 0; r < 16; ++r) p0[r] = __builtin_amdgcn_exp2f(p0[r]);
}
template <bool DEFER>
__device__ __forceinline__ void finishSM(f32x16& p0, f32x16& p1, float alpha, float& l_reg, bf16x8& pa0, bf16x8& pa1, bf16x8& pa2, bf16x8& pa3) {
#pragma unroll
    for (int r = 0; r < 16; ++r) p1[r] = __builtin_amdgcn_exp2f(p1[r]);
    float ps = 0;
#pragma unroll
    for (int r = 0; r < 16; ++r) ps += p0[r];
#pragma unroll
    for (int r = 0; r < 16; ++r) ps += p1[r];
    if constexpr (!DEFER) { auto rr = __builtin_amdgcn_permlane32_swap(__float_as_uint(ps), __float_as_uint(ps), false, false);
      ps = __uint_as_float(rr[0]) + __uint_as_float(rr[1]); }
    l_reg = l_reg * alpha + ps;
#define PK4(P, BASE, OUT) do { u32x4 w = {cvt_pk_bf16(P[BASE + 0], P[BASE + 1]), cvt_pk_bf16(P[BASE + 2], P[BASE + 3]), cvt_pk_bf16(P[BASE + 4], P[BASE + 5]), cvt_pk_bf16(P[BASE + 6], P[BASE + 7])}; \
    OUT = *reinterpret_cast<bf16x8*>(&w); } while (0)
    PK4(p0, 0, pa0); PK4(p0, 8, pa1); PK4(p1, 0, pa2); PK4(p1, 8, pa3);
#undef PK4
}
template <int DQK> struct KB { static constexpr int NB = DQK == 192 ? 4 : 8; int b[NB]; };
template <int DQK, bool ZINIT, bool QREG = false>
__device__ __forceinline__ void qkt(f32x16& p0, f32x16& p1, const char* Ks, const bf16x8* qr, const char* qrl, const KB<DQK>& kb, float negm) {
    if constexpr (!ZINIT) {
#pragma unroll
        for (int r = 0; r < 16; ++r) { p0[r] = negm; p1[r] = negm; } }
    constexpr int NB = KB<DQK>::NB;
#pragma unroll
    for (int d0 = 0; d0 < DQK / 16; ++d0) {
        const char* a = Ks + kb.b[d0 % NB] + (d0 / NB) * (NB * 32);
        bf16x8 b0 = *reinterpret_cast<const bf16x8*>(a);
        bf16x8 b1 = *reinterpret_cast<const bf16x8*>(a + 32 * (DQK * 2));
        bf16x8 q;
        if (d0 < 8 || QREG) q = qr[d0]; else q = *reinterpret_cast<const bf16x8*>(qrl + (d0 - 8) * 1024);
        if (ZINIT && d0 == 0) { p0 = __builtin_amdgcn_mfma_f32_32x32x16_bf16(b0, q, f32x16{}, 0, 0, 0);
                                p1 = __builtin_amdgcn_mfma_f32_32x32x16_bf16(b1, q, f32x16{}, 0, 0, 0); }
        else { p0 = __builtin_amdgcn_mfma_f32_32x32x16_bf16(b0, q, p0, 0, 0, 0);
               p1 = __builtin_amdgcn_mfma_f32_32x32x16_bf16(b1, q, p1, 0, 0, 0); }
    }
}
__device__ __forceinline__ int v_st(int k, int c) { const int kk = k; return ((kk >> 3) * 4 + (c >> 5)) * 512 + ((kk & 7) * 32 + (c & 31)) * 2; }
__device__ __forceinline__ int v_rd_base(int lane) { return ((lane & 3) << 3) | (((lane >> 2) & 3) << 6) | (((lane >> 4) & 1) << 5) | (((lane >> 5) & 1) << 8); }
constexpr int v_rd_off(int d0, int ks, int half) { return d0 * 512 + ks * 4096 + half * 2048; }
template <int OFF> __device__ __forceinline__ s16x4 tr_read(int vb) {
    s16x4 r; asm volatile("ds_read_b64_tr_b16 %0, %1 offset:%2" : "=&v"(r) : "v"(vb), "i"(OFF) : "memory"); return r;
}
template <int D0> __device__ __forceinline__ void pv_one(f32x16& od, int vb, bf16x8 pa0, bf16x8 pa1, bf16x8 pa2, bf16x8 pa3) {
    const s16x4 l0 = tr_read<v_rd_off(D0, 0, 0)>(vb), h0 = tr_read<v_rd_off(D0, 0, 1)>(vb), l1 = tr_read<v_rd_off(D0, 1, 0)>(vb), h1 = tr_read<v_rd_off(D0, 1, 1)>(vb);
    const s16x4 l2 = tr_read<v_rd_off(D0, 2, 0)>(vb), h2 = tr_read<v_rd_off(D0, 2, 1)>(vb), l3 = tr_read<v_rd_off(D0, 3, 0)>(vb), h3 = tr_read<v_rd_off(D0, 3, 1)>(vb);
    asm volatile("s_waitcnt lgkmcnt(0)" ::: "memory"); SBAR();
#define PK(L, H) (bf16x8){L[0], L[1], L[2], L[3], H[0], H[1], H[2], H[3]}
    od = __builtin_amdgcn_mfma_f32_32x32x16_bf16(pa0, PK(l0, h0), od, 0, 0, 0);
    od = __builtin_amdgcn_mfma_f32_32x32x16_bf16(pa1, PK(l1, h1), od, 0, 0, 0);
    od = __builtin_amdgcn_mfma_f32_32x32x16_bf16(pa2, PK(l2, h2), od, 0, 0, 0);
    od = __builtin_amdgcn_mfma_f32_32x32x16_bf16(pa3, PK(l3, h3), od, 0, 0, 0);
#undef PK
}
__device__ __forceinline__ void pv_d0(f32x16* o, int vb, bf16x8 pa0, bf16x8 pa1, bf16x8 pa2, bf16x8 pa3) {
    pv_one<0>(o[0], vb, pa0, pa1, pa2, pa3); pv_one<1>(o[1], vb, pa0, pa1, pa2, pa3); pv_one<2>(o[2], vb, pa0, pa1, pa2, pa3); pv_one<3>(o[3], vb, pa0, pa1, pa2, pa3);
}

template <int LDO>
__device__ __forceinline__ void epilogue(const f32x16 (&o)[4], bf16_t* __restrict__ Ob, char* wsbase, char* kstage) {
    int tid_ = threadIdx.x; asm volatile("" : "+v"(tid_));
    const int wid = tid_ >> 6, lane = tid_ & 63, r32 = lane & 31, hi = lane >> 5;
    const float* li_l = (const float*)wsbase + wid * 64;
    float rli[16];
#pragma unroll
    for (int r = 0; r < 16; ++r) rli[r] = __builtin_amdgcn_rcpf(li_l[crow(r, hi)]);
    GAS bf16_t* Ow = (GAS bf16_t*)Ob + (long)(wid * QBLK) * LDO;
    char* stg = kstage + wid * 4096;
#pragma unroll
    for (int half = 0; half < 2; ++half) {
#pragma unroll
        for (int dd = 0; dd < 2; ++dd)
#pragma unroll
            for (int r = 0; r < 16; ++r) *(bf16_t*)(stg + crow(r, hi) * 128 + (dd * 32 + r32) * 2) = f2bf(o[half * 2 + dd][r] * rli[r]);
        asm volatile("s_waitcnt lgkmcnt(0)" ::: "memory");
#pragma unroll
        for (int i = 0; i < 4; ++i) { const int row = i * 8 + (lane >> 3), ch = lane & 7;
            const u32x4 v = *(const u32x4*)(stg + row * 128 + ch * 16);
            *(GAS u32x4*)(Ow + (long)row * LDO + half * 64 + ch * 8) = v; }
        asm volatile("s_waitcnt lgkmcnt(0)" ::: "memory");
    }
}
template <int DQK, int LDQ, int LDK, int LDV, int LDO, int SDEPTH, bool NOMAX = false>
__device__ __forceinline__ void attn_body(const bf16_t* __restrict__ Qb_, const bf16_t* __restrict__ Kh_, const bf16_t* __restrict__ Krh_, const bf16_t* __restrict__ Vh_,
                                          bf16_t* __restrict__ Ob, int seq, int qpos0, char* lds) {
    using C = Cfg<DQK>;
    const GAS bf16_t* Qb = (const GAS bf16_t*)Qb_; const GAS bf16_t* Kh = (const GAS bf16_t*)Kh_; const GAS bf16_t* Krh = (const GAS bf16_t*)Krh_; const GAS bf16_t* Vh = (const GAS bf16_t*)Vh_;
    constexpr size_t SHM_V = C::SHM_V, SHM_K = C::SHM_K;
    constexpr bool HASR = DQK == 192;
    constexpr bool QREG = HASR && NOMAX;
    int tid_ = threadIdx.x; asm volatile("" : "+v"(tid_));
    const int tid = tid_, wid = tid >> 6, lane = tid & 63, r32 = lane & 31, hi = lane >> 5;
    char* V_lds = lds; char* K_lds = lds + 2 * SHM_V;
    float* ws = (float*)(lds + 2 * SHM_V + 2 * SHM_K) + wid * 64; float* li_l = ws; float* al_l = ws + 32;
    float m_reg = 0.f, l_reg = 0; f32x16 o[4] = {}; bf16x8 qr[QREG ? 12 : 8];
    const GAS bf16_t* Qw = Qb + (long)(wid * QBLK + r32) * LDQ + hi * 8;
    constexpr float QC = C::SCALE * 1.4426950408889634f;
#pragma unroll
    for (int d0 = 0; d0 < 8; ++d0) { const bf16x8 q = *(const GAS bf16x8*)(Qw + d0 * 16);
        u32x4 w; w.x = cvt_pk_bf16(bf2f((bf16_t)q[0]) * QC, bf2f((bf16_t)q[1]) * QC); w.y = cvt_pk_bf16(bf2f((bf16_t)q[2]) * QC, bf2f((bf16_t)q[3]) * QC);
        w.z = cvt_pk_bf16(bf2f((bf16_t)q[4]) * QC, bf2f((bf16_t)q[5]) * QC); w.w = cvt_pk_bf16(bf2f((bf16_t)q[6]) * QC, bf2f((bf16_t)q[7]) * QC);
        qr[d0] = *reinterpret_cast<bf16x8*>(&w); }
    char* qrl = lds + 2 * SHM_V + 2 * SHM_K + NW * 64 * 4 + (wid * 4 * 64 + lane) * 16;
    if constexpr (HASR) {
        const int s = qpos0 + wid * QBLK + r32; const float prow = (float)(s >> 6), pcol = (float)(s & 63);
        const bf16x8 q8 = *(const GAS bf16x8*)(Qw + 128), q9 = *(const GAS bf16x8*)(Qw + 144),
                     q10 = *(const GAS bf16x8*)(Qw + 160), q11 = *(const GAS bf16x8*)(Qw + 176);
        float a1[8], a2[8], b1[8], b2[8];
#pragma unroll
        for (int e = 0; e < 8; ++e) { const float f = __builtin_amdgcn_exp2f(-(float)(hi * 8 + e) * (LOG2_THETA / 16.f));
            float sn, cs; sincos_hw(prow * f, sn, cs);
            float x1 = bf2f((bf16_t)q8[e]) * QC, x2 = bf2f((bf16_t)q9[e]) * QC; a1[e] = x1 * cs - x2 * sn; a2[e] = x2 * cs + x1 * sn;
            sincos_hw(pcol * f, sn, cs);
            x1 = bf2f((bf16_t)q10[e]) * QC; x2 = bf2f((bf16_t)q11[e]) * QC; b1[e] = x1 * cs - x2 * sn; b2[e] = x2 * cs + x1 * sn; }
        const u32x4 w0 = (u32x4){cvt_pk_bf16(a1[0], a1[1]), cvt_pk_bf16(a1[2], a1[3]), cvt_pk_bf16(a1[4], a1[5]), cvt_pk_bf16(a1[6], a1[7])};
        const u32x4 w1 = (u32x4){cvt_pk_bf16(a2[0], a2[1]), cvt_pk_bf16(a2[2], a2[3]), cvt_pk_bf16(a2[4], a2[5]), cvt_pk_bf16(a2[6], a2[7])};
        const u32x4 w2 = (u32x4){cvt_pk_bf16(b1[0], b1[1]), cvt_pk_bf16(b1[2], b1[3]), cvt_pk_bf16(b1[4], b1[5]), cvt_pk_bf16(b1[6], b1[7])};
        const u32x4 w3 = (u32x4){cvt_pk_bf16(b2[0], b2[1]), cvt_pk_bf16(b2[2], b2[3]), cvt_pk_bf16(b2[4], b2[5]), cvt_pk_bf16(b2[6], b2[7])};
        if constexpr (QREG) { qr[QREG ? 8 : 0] = *reinterpret_cast<const bf16x8*>(&w0); qr[QREG ? 9 : 0] = *reinterpret_cast<const bf16x8*>(&w1);
                              qr[QREG ? 10 : 0] = *reinterpret_cast<const bf16x8*>(&w2); qr[QREG ? 11 : 0] = *reinterpret_cast<const bf16x8*>(&w3); }
        else { *(u32x4*)(qrl) = w0; *(u32x4*)(qrl + 1024) = w1; *(u32x4*)(qrl + 2048) = w2; *(u32x4*)(qrl + 3072) = w3; }
    }
    const int sr = tid >> 4, sc = (tid & 15) * 8, vst0 = v_st(sr, sc), vst1 = v_st(32 + sr, sc);
    const int rr_ = tid >> 3, rc_ = (tid & 7) * 8;
    const int vb0 = (int)(uintptr_t)V_lds + v_rd_base(lane);
    KB<DQK> kb;
#pragma unroll
    for (int q = 0; q < KB<DQK>::NB; ++q) kb.b[q] = kswz<DQK>(r32, (q * 16 + hi * 8) * 2);
    struct { bf16x8 vs0, vs1, ks0, ks1, kr; } sr_[SDEPTH];
#define SLOAD(i, k0) do { sr_[i].vs0 = *(const GAS bf16x8*)(&Vh[(long)((k0) + sr) * LDV + sc]); sr_[i].vs1 = *(const GAS bf16x8*)(&Vh[(long)((k0) + 32 + sr) * LDV + sc]); \
    sr_[i].ks0 = *(const GAS bf16x8*)(&Kh[(long)((k0) + sr) * LDK + sc]); sr_[i].ks1 = *(const GAS bf16x8*)(&Kh[(long)((k0) + 32 + sr) * LDK + sc]); \
    if constexpr (HASR) sr_[i].kr = *(const GAS bf16x8*)(&Krh[(long)((k0) + rr_) * 64 + rc_]); } while (0)
#define SWRITE(b, i) do { *(bf16x8*)(V_lds + (b) * SHM_V + vst0) = sr_[i].vs0;          \
    *(bf16x8*)(V_lds + (b) * SHM_V + vst1) = sr_[i].vs1; const int kc = sc * 2;               \
    *(bf16x8*)(K_lds + (b) * SHM_K + kswz<DQK>(sr, kc)) = sr_[i].ks0;                       \
    *(bf16x8*)(K_lds + (b) * SHM_K + kswz<DQK>(32 + sr, kc)) = sr_[i].ks1;                  \
    if constexpr (HASR) *(bf16x8*)(K_lds + (b) * SHM_K + kswz<DQK>(rr_, 256 + rc_ * 2)) = sr_[i].kr; } while (0)
#define SWAIT() do { if constexpr (SDEPTH == 2) { if constexpr (HASR) asm volatile("s_waitcnt vmcnt(5)" ::: "memory"); else asm volatile("s_waitcnt vmcnt(4)" ::: "memory"); } \
    else asm volatile("s_waitcnt vmcnt(0)" ::: "memory"); } while (0)
#define RESC(a) do { if constexpr (!NOMAX) if (__any((a) < 1.f)) { if (hi == 0) al_l[r32] = (a); asm volatile("s_waitcnt lgkmcnt(0)" ::: "memory"); \
    _Pragma("unroll") for (int d = 0; d < 4; ++d) _Pragma("unroll") for (int r = 0; r < 16; ++r) o[d][r] *= al_l[crow(r, hi)]; } } while (0)
    f32x16 pA0, pA1, pB0, pB1; float alA, alB; bf16x8 pa0, pa1, pa2, pa3; const int NT = seq / KVBLK;
    constexpr int SE = 0, SO = SDEPTH - 1;
    SLOAD(SE, 0); asm volatile("s_waitcnt vmcnt(0)" ::: "memory"); SWRITE(0, SE); __syncthreads();
    qkt<DQK, NOMAX, QREG>(pA0, pA1, K_lds, qr, qrl, kb, 0.f); partialSM<NOMAX ? 2 : 1>(pA0, pA1, m_reg, alA);
    SLOAD(SO, KVBLK); if constexpr (SDEPTH == 2) { if (2 < NT) SLOAD(SE, 2 * KVBLK); }
    SWAIT(); SWRITE(1, SO); __syncthreads();
    for (int j = 1; j + 1 < NT; j += 2) {
        SBAR(); qkt<DQK, NOMAX, QREG>(pB0, pB1, K_lds + SHM_K, qr, qrl, kb, -m_reg);
        finishSM<NOMAX>(pA0, pA1, alA, l_reg, pa0, pa1, pa2, pa3); SBAR();
        SLOAD(SO, (j + SDEPTH) * KVBLK); SBAR();
        pv_d0(o, vb0, pa0, pa1, pa2, pa3); partialSM<NOMAX ? 2 : 0>(pB0, pB1, m_reg, alB);
        __syncthreads(); SWAIT(); SWRITE(0, SE);
        RESC(alB); __syncthreads();
        SBAR(); qkt<DQK, NOMAX, QREG>(pA0, pA1, K_lds, qr, qrl, kb, -m_reg);
        finishSM<NOMAX>(pB0, pB1, alB, l_reg, pa0, pa1, pa2, pa3); SBAR();
        if (SDEPTH == 1 || j + 3 < NT) SLOAD(SE, (j + 1 + SDEPTH) * KVBLK); SBAR();
        pv_d0(o, vb0 + (int)SHM_V, pa0, pa1, pa2, pa3); partialSM<NOMAX ? 2 : 0>(pA0, pA1, m_reg, alA);
        __syncthreads(); SWAIT(); SWRITE(1, SO);
        RESC(alA); __syncthreads();
    }
    SBAR(); qkt<DQK, NOMAX, QREG>(pB0, pB1, K_lds + SHM_K, qr, qrl, kb, -m_reg);
    finishSM<NOMAX>(pA0, pA1, alA, l_reg, pa0, pa1, pa2, pa3); SBAR();
    pv_d0(o, vb0, pa0, pa1, pa2, pa3); partialSM<NOMAX ? 2 : 0>(pB0, pB1, m_reg, alB);
    __syncthreads(); RESC(alB);
    finishSM<NOMAX>(pB0, pB1, alB, l_reg, pa0, pa1, pa2, pa3); SBAR();
    pv_d0(o, vb0 + (int)SHM_V, pa0, pa1, pa2, pa3);
    if constexpr (NOMAX) { auto rr = __builtin_amdgcn_permlane32_swap(__float_as_uint(l_reg), __float_as_uint(l_reg), false, false); l_reg = __uint_as_float(rr[0]) + __uint_as_float(rr[1]); }
    if (hi == 0) li_l[r32] = l_reg; asm volatile("s_waitcnt lgkmcnt(0)" ::: "memory");
    epilogue<LDO>(o, Ob, lds + 2 * SHM_V + 2 * SHM_K, lds + 2 * SHM_V);
    asm volatile("s_waitcnt vmcnt(0)" ::: "memory");
    __syncthreads();
#undef SLOAD
#undef SWRITE
#undef SWAIT
#undef RESC
}
#if 0
    float rli[16];
#pragma unroll
    for (int r = 0; r < 16; ++r) rli[r] = __builtin_amdgcn_rcpf(li_l[crow(r, hi)]);
    bf16_t* Ow = Ob + (long)(wid * QBLK) * LDO;
#pragma unroll
    for (int r = 0; r < 16; ++r) { const int orow = crow(r, hi);
#pragma unroll
        for (int d0 = 0; d0 < 4; ++d0) Ow[(long)orow * LDO + d0 * 32 + r32] = f2bf(o[d0][r] * rli[r]); }
    asm volatile("s_waitcnt vmcnt(0)" ::: "memory");
    __syncthreads();
#endif
}

#define XB_TMO      128
#define XB_XCNT(j)  (256  + 64 * (j))
#define XB_XSUB(j)  (1280 + 64 * (j))
#define XB_XGEN(j)  (2304 + 64 * (j))
#define XB_TOP      3328
#define XB_TOPGEN   3392
#define XCD_BAR_WORDS 3456
#define XB_SPIN_CAP (1u << 22)
__device__ __forceinline__ unsigned xb_ld(unsigned* p)              { return __hip_atomic_load(p, __ATOMIC_RELAXED, __HIP_MEMORY_SCOPE_AGENT); }
__device__ __forceinline__ unsigned xb_add(unsigned* p, unsigned v) { return __hip_atomic_fetch_add(p, v, __ATOMIC_RELAXED, __HIP_MEMORY_SCOPE_AGENT); }
__device__ __forceinline__ unsigned xb_xcc_id() { return (unsigned)__builtin_amdgcn_s_getreg((3 << 11) | 20) & 0xFu; }
#define XB_SPIN(cond, bar) do { unsigned _sp = 0; while (cond) { __builtin_amdgcn_s_sleep(1); \
    if ((++_sp & 255u) == 0u) { if (xb_ld(&(bar)[XB_TMO])) break; if (_sp > XB_SPIN_CAP) { atomicAdd(&(bar)[XB_TMO], 1u); break; } } } } while (0)
struct XcdBarrier { unsigned* bar; unsigned x; volatile LAS unsigned* st; };
__device__ __forceinline__ XcdBarrier xcd_barrier_post(unsigned* bar, volatile LAS unsigned* st) {
    XcdBarrier b; b.bar = bar; b.x = xb_xcc_id(); b.st = st;
    if (threadIdx.x == 0) (void)xb_add(&bar[XB_XCNT(b.x)], 1u);
    return b;
}
__device__ __forceinline__ void xcd_barrier_complete(unsigned* bar, unsigned x, unsigned& nloc, unsigned& nx) {
    const unsigned G = gridDim.x * gridDim.y * gridDim.z;
    unsigned sum, cnt, mine, sp = 0u;
    for (;;) {
        sum = 0u; cnt = 0u; mine = 0u;
#pragma unroll
        for (unsigned j = 0; j < 16; ++j) { const unsigned c = xb_ld(&bar[XB_XCNT(j)]); sum += c; cnt += (c > 0u) ? 1u : 0u; mine = (j == x) ? c : mine; }
        if (sum == G) break;
        __builtin_amdgcn_s_sleep(1);
        if ((++sp & 255u) == 0u) { if (xb_ld(&bar[XB_TMO])) break; if (sp > XB_SPIN_CAP) { atomicAdd(&bar[XB_TMO], 1u); break; } }
    }
    nloc = mine > 0u ? mine : 1u; nx = cnt > 0u ? cnt : 1u;
}
__device__ __forceinline__ void xcd_barrier(const XcdBarrier& b) {
    asm volatile("s_waitcnt vmcnt(0)" ::: "memory");
    __syncthreads();
    if (threadIdx.x == 0) {
        unsigned* bar = b.bar; asm volatile("" : "+s"(bar));
        __builtin_amdgcn_s_waitcnt(0);
        unsigned nloc = b.st[0], nx = b.st[1];
        if (nloc == 0u) { xcd_barrier_complete(bar, b.x, nloc, nx); b.st[0] = nloc; b.st[1] = nx; }
        const unsigned old = xb_add(&bar[XB_XSUB(b.x)], 1u);
        const unsigned gen = old / nloc;
        if (old + 1u == (gen + 1u) * nloc) {
            __builtin_amdgcn_fence(__ATOMIC_RELEASE, "agent");
            asm volatile("s_waitcnt vmcnt(0)" ::: "memory");
            const unsigned og = xb_add(&bar[XB_TOP], 1u);
            const unsigned tg = og / nx;
            if (og + 1u == (tg + 1u) * nx) xb_add(&bar[XB_TOPGEN], 1u);
            else XB_SPIN(xb_ld(&bar[XB_TOPGEN]) == tg, bar);
            __builtin_amdgcn_fence(__ATOMIC_ACQUIRE, "agent");
            xb_add(&bar[XB_XGEN(b.x)], 1u);
            asm volatile("s_waitcnt vmcnt(0)" ::: "memory");
        } else {
            XB_SPIN(xb_ld(&bar[XB_XGEN(b.x)]) == gen, bar);
            __builtin_amdgcn_fence(__ATOMIC_ACQUIRE, "agent");
            asm volatile("s_waitcnt vmcnt(0)" ::: "memory");
        }
    }
    __syncthreads();
}

struct Params {
    const float* in[15];
    float* out;
    unsigned char* ws;
    int ph_lo, ph_hi;
};

__device__ __forceinline__ void transpose_item(const float* W, int K, int N, bf16_t* WT, LAS float* scr, int item, int lane, const float* gain = nullptr) {
    const int nblk = N / 32, kb = item / nblk, nb = item % nblk, k0 = 64 * kb, n0 = 32 * nb;
#pragma unroll 8
    for (int i = 0; i < 32; ++i) { const int kk = 2 * i + (lane >> 5); scr[kk * 33 + (lane & 31)] = W[(size_t)(k0 + kk) * N + n0 + (lane & 31)]; }
    asm volatile("s_waitcnt lgkmcnt(0)" ::: "memory");
    const int c = lane & 7;
    f32x4 g0 = {1.f, 1.f, 1.f, 1.f}, g1 = g0;
    if (gain) { g0 = *(const f32x4*)(gain + k0 + 8 * c); g1 = *(const f32x4*)(gain + k0 + 8 * c + 4); }
#pragma unroll
    for (int j = 0; j < 4; ++j) { const int n = (lane >> 3) + 8 * j; const LAS float* s = scr + (8 * c) * 33 + n;
        u32x4 o; o.x = cvt_pk_bf16(s[0 * 33] * g0[0], s[1 * 33] * g0[1]); o.y = cvt_pk_bf16(s[2 * 33] * g0[2], s[3 * 33] * g0[3]); o.z = cvt_pk_bf16(s[4 * 33] * g1[0], s[5 * 33] * g1[1]); o.w = cvt_pk_bf16(s[6 * 33] * g1[2], s[7 * 33] * g1[3]);
        *(u32x4*)(WT + (size_t)(n0 + n) * K + k0 + 8 * c) = o; }
    asm volatile("s_waitcnt lgkmcnt(0)" ::: "memory");
}

__device__ __forceinline__ void phase_weights(const Params& p, int layer, LAS unsigned char* lds, int gw, int NGW, int wave, int lane) {
    LAS float* scr = (LAS float*)(lds + wave * 8704);
    size_t wz_ = 0; asm volatile("" : "+s"(wz_)); unsigned char* ws = p.ws + wz_;
    const float* w_in = p.in[3] + (size_t)layer * DM * INW;
    const float* w_q = p.in[5] + (size_t)layer * QLORA * QA_W;
    const float* w_kv = p.in[7] + (size_t)layer * KVLORA * KVA_W;
    const float* w_o = p.in[10] + (size_t)layer * DM * DM;
    const float* w_up = p.in[12] + (size_t)layer * DM * DFF;
    const float* w_dn = p.in[13] + (size_t)layer * DFF * DM;
    constexpr int I_IN = (DM / 64) * (INW / 32), I_Q = (QLORA / 64) * (QA_W / 32), I_KV = (KVLORA / 64) * (KVA_W / 32), I_O = (DM / 64) * (DM / 32),
                  I_UP = (DM / 64) * (DFF / 32), I_DN = (DFF / 64) * (DM / 32), NITEMS = I_IN + I_Q + I_KV + I_O + I_UP + I_DN;
    for (int it = gw; it < NITEMS; it += NGW) {
        int r = it;
        if (r < I_IN) { transpose_item(w_in, DM, INW, (bf16_t*)(ws + W_IN), scr, r, lane); continue; } r -= I_IN;
        if (r < I_Q) { transpose_item(w_q, QLORA, QA_W, (bf16_t*)(ws + W_Q), scr, r, lane); continue; } r -= I_Q;
        if (r < I_KV) { transpose_item(w_kv, KVLORA, KVA_W, (bf16_t*)(ws + W_KV), scr, r, lane); continue; } r -= I_KV;
        if (r < I_O) { transpose_item(w_o, DM, DM, (bf16_t*)(ws + W_O), scr, r, lane); continue; } r -= I_O;
        if (r < I_UP) { transpose_item(w_up, DM, DFF, (bf16_t*)(ws + W_UP), scr, r, lane, p.in[11] + layer * DM); continue; } r -= I_UP;
        transpose_item(w_dn, DFF, DM, (bf16_t*)(ws + W_DN), scr, r, lane);
    }
    u32x4* pad = (u32x4*)(ws + W_IN + (size_t)INW * DM * 2);
    unsigned zz = 0u; asm volatile("" : "+v"(zz));
    for (int i = gw * 64 + lane; i < 64 * DM * 2 / 16; i += NGW * 64) pad[i] = (u32x4){zz, zz, zz, zz};
}

__device__ __forceinline__ void ld8f(const bf16_t* p, float (&v)[8]) {
    const u32x4 w = *(const u32x4*)p;
    v[0] = __uint_as_float(w.x << 16); v[1] = __uint_as_float(w.x & 0xffff0000u); v[2] = __uint_as_float(w.y << 16); v[3] = __uint_as_float(w.y & 0xffff0000u);
    v[4] = __uint_as_float(w.z << 16); v[5] = __uint_as_float(w.z & 0xffff0000u); v[6] = __uint_as_float(w.w << 16); v[7] = __uint_as_float(w.w & 0xffff0000u);
}
__device__ __forceinline__ void st8f(bf16_t* p, const float (&v)[8]) {
    u32x4 w; w.x = cvt_pk_bf16(v[0], v[1]); w.y = cvt_pk_bf16(v[2], v[3]); w.z = cvt_pk_bf16(v[4], v[5]); w.w = cvt_pk_bf16(v[6], v[7]); *(u32x4*)p = w;
}
__device__ __forceinline__ void rms_row_to_bf16(const float* xrow, const f32x4 (&g)[4], bf16_t* orow, int lane) {
    const f32x4* xr = (const f32x4*)xrow + lane;
    f32x4 v[4]; float s = 0.f;
#pragma unroll
    for (int j = 0; j < 4; ++j) { v[j] = xr[64 * j]; s += (v[j].x * v[j].x + v[j].y * v[j].y) + (v[j].z * v[j].z + v[j].w * v[j].w); }
    const float rstd = 1.f / sqrtf(wave_sum(s) * (1.f / DM) + EPS);
    u32x2* o8 = (u32x2*)orow + lane;
#pragma unroll
    for (int j = 0; j < 4; ++j) { u32x2 w; w.x = cvt_pk_bf16(v[j].x * rstd * g[j].x, v[j].y * rstd * g[j].y); w.y = cvt_pk_bf16(v[j].z * rstd * g[j].z, v[j].w * rstd * g[j].w); o8[64 * j] = w; }
}
__device__ __forceinline__ void phase_norm(const float* x_lo, const float* x_hi, const float* gain, bf16_t* H, int gw, int NGW, int lane) {
    f32x4 g[4];
#pragma unroll
    for (int j = 0; j < 4; ++j) g[j] = ((const f32x4*)gain)[lane + 64 * j];
    for (int m = gw; m < T; m += NGW) {
        const float* xr = m < T_PROMPT ? x_lo + (size_t)m * DM : x_hi + (size_t)(m - T_PROMPT) * DM;
        rms_row_to_bf16(xr, g, H + (size_t)m * DM, lane);
    }
}
__device__ __forceinline__ void phase_norm_b16(const bf16_t* Xb, const float* gain, bf16_t* H, int gw, int NGW, int lane) {
    f32x4 g[4];
#pragma unroll
    for (int j = 0; j < 2; ++j) { g[2 * j] = *(const f32x4*)(gain + 512 * j + 8 * lane); g[2 * j + 1] = *(const f32x4*)(gain + 512 * j + 8 * lane + 4); }
    for (int m = gw; m < T; m += NGW) {
        float v[2][8]; float s = 0.f;
#pragma unroll
        for (int j = 0; j < 2; ++j) { ld8f(Xb + (size_t)m * DM + 512 * j + 8 * lane, v[j]);
#pragma unroll
            for (int e = 0; e < 8; ++e) s += v[j][e] * v[j][e]; }
        const float rstd = 1.f / sqrtf(wave_sum(s) * (1.f / DM) + EPS);
#pragma unroll
        for (int j = 0; j < 2; ++j) {
#pragma unroll
            for (int e = 0; e < 8; ++e) v[j][e] *= rstd * g[2 * j + (e >> 2)][e & 3];
            st8f(H + (size_t)m * DM + 512 * j + 8 * lane, v[j]); }
    }
}
__device__ __forceinline__ void phase_rowstats(const bf16_t* Xb, float* RS, int gw, int NGW, int lane) {
    for (int m = gw; m < T; m += NGW) {
        float v[2][8]; float s = 0.f;
#pragma unroll
        for (int j = 0; j < 2; ++j) { ld8f(Xb + (size_t)m * DM + 512 * j + 8 * lane, v[j]);
#pragma unroll
            for (int e = 0; e < 8; ++e) s += v[j][e] * v[j][e]; }
        const float rstd = 1.f / sqrtf(wave_sum(s) * (1.f / DM) + EPS);
        if (lane == 0) RS[m] = rstd;
    }
}
__device__ __forceinline__ void phase_final_norm_b16(const bf16_t* Xb, float* out, const float* gain, int gw, int NGW, int lane) {
    f32x4 g[4];
#pragma unroll
    for (int j = 0; j < 2; ++j) { g[2 * j] = *(const f32x4*)(gain + 512 * j + 8 * lane); g[2 * j + 1] = *(const f32x4*)(gain + 512 * j + 8 * lane + 4); }
    for (int m = gw; m < T; m += NGW) {
        float v[2][8]; float s = 0.f;
#pragma unroll
        for (int j = 0; j < 2; ++j) { ld8f(Xb + (size_t)m * DM + 512 * j + 8 * lane, v[j]);
#pragma unroll
            for (int e = 0; e < 8; ++e) s += v[j][e] * v[j][e]; }
        const float rstd = 1.f / sqrtf(wave_sum(s) * (1.f / DM) + EPS);
#pragma unroll
        for (int j = 0; j < 2; ++j) { float* o = out + (size_t)m * DM + 512 * j + 8 * lane;
            *(f32x4*)o = (f32x4){v[j][0], v[j][1], v[j][2], v[j][3]} * rstd * g[2 * j];
            *(f32x4*)(o + 4) = (f32x4){v[j][4], v[j][5], v[j][6], v[j][7]} * rstd * g[2 * j + 1]; }
    }
}
__device__ __forceinline__ void phase_final_norm(float* X, const float* gain, int gw, int NGW, int lane) {
    f32x4 g[4];
#pragma unroll
    for (int j = 0; j < 4; ++j) g[j] = ((const f32x4*)gain)[lane + 64 * j];
    for (int m = gw; m < T; m += NGW) {
        f32x4* xr = (f32x4*)(X + (size_t)m * DM) + lane;
        f32x4 v[4]; float s = 0.f;
#pragma unroll
        for (int j = 0; j < 4; ++j) { v[j] = xr[64 * j]; s += (v[j].x * v[j].x + v[j].y * v[j].y) + (v[j].z * v[j].z + v[j].w * v[j].w); }
        const float rstd = 1.f / sqrtf(wave_sum(s) * (1.f / DM) + EPS);
#pragma unroll
        for (int j = 0; j < 4; ++j) xr[64 * j] = v[j] * rstd * g[j];
    }
}

__device__ __forceinline__ float sum8lanes(float v) { const int l = lane_opaque(); v += shx(v, 1, l); v += shx(v, 2, l); v += shx(v, 4, l); return v; }
__device__ __forceinline__ void head_norm_rope(const bf16_t* za, const float* g, bf16_t* out, int sl, const float (&sr)[8], const float (&cr)[8], const float (&sc)[8], const float (&cc)[8]) {
    float a[8], b[8], ga[8], gb[8]; ld8f(za, a); ld8f(za + 64, b);
    *(f32x4*)&ga[0] = *(const f32x4*)(g + 8 * sl); *(f32x4*)&ga[4] = *(const f32x4*)(g + 8 * sl + 4);
    *(f32x4*)&gb[0] = *(const f32x4*)(g + 64 + 8 * sl); *(f32x4*)&gb[4] = *(const f32x4*)(g + 64 + 8 * sl + 4);
    float ss = 0.f;
#pragma unroll
    for (int e = 0; e < 8; ++e) ss += a[e] * a[e] + b[e] * b[e];
    const float rstd = 1.f / sqrtf(sum8lanes(ss) * (1.f / HD) + EPS);
    const bool second = sl >= 4; const int ln = lane_opaque();
#pragma unroll
    for (int e = 0; e < 8; ++e) { const float xa = a[e] * rstd * ga[e], xb = b[e] * rstd * gb[e];
        const float ya = shx(xa, 4, ln), yb = shx(xb, 4, ln);
        a[e] = second ? (xa * cr[e] + ya * sr[e]) : (xa * cr[e] - ya * sr[e]);
        b[e] = second ? (xb * cc[e] + yb * sc[e]) : (xb * cc[e] - yb * sc[e]); }
    st8f(out, a); st8f(out + 64, b);
}
__device__ __forceinline__ void phase_post(const Params& p, int layer, int gw, int NGW, int lane) {
    size_t wz_ = 0; asm volatile("" : "+s"(wz_)); unsigned char* ws = p.ws + wz_;
    const bf16_t* Z = (const bf16_t*)(ws + A_Z);
    bf16_t* CQN = (bf16_t*)(ws + A_CQN); bf16_t* CKVN = (bf16_t*)(ws + A_CKVN); bf16_t* KR = (bf16_t*)(ws + A_KR);
    bf16_t* QB = (bf16_t*)(ws + A_QB); bf16_t* KB = (bf16_t*)(ws + A_KB); bf16_t* VB = (bf16_t*)(ws + A_VB);
    const float* gq = p.in[4] + layer * QLORA; const float* gkv = p.in[6] + layer * KVLORA;
    const float* gbq = p.in[8] + layer * HD; const float* gbk = p.in[9] + layer * HD;
    const int sl = lane & 7, tw = lane >> 3;
    float f64[8], f32_[8];
#pragma unroll
    for (int e = 0; e < 8; ++e) { f64[e] = __builtin_amdgcn_exp2f(-(float)(8 * (sl & 3) + e) * (LOG2_THETA / 32.f));
                                  f32_[e] = __builtin_amdgcn_exp2f(-(float)(8 * (sl & 1) + e) * (LOG2_THETA / 16.f)); }
    float krmax = 0.f;
    for (int grp = gw; grp < T / 8; grp += NGW) {
        const int tok = grp * 8 + tw;
        const bf16_t* z = Z + (size_t)tok * INW_PAD + 8 * sl;
        const int s = seq_pos(tok); const float prow = (float)(s >> 6), pcol = (float)(s & 63);
        { float v[6][8]; float ss = 0.f;
#pragma unroll
          for (int c = 0; c < 6; ++c) { ld8f(z + 64 * c, v[c]);
#pragma unroll
              for (int e = 0; e < 8; ++e) ss += v[c][e] * v[c][e]; }
          const float rstd = 1.f / sqrtf(sum8lanes(ss) * (1.f / QLORA) + EPS);
#pragma unroll
          for (int c = 0; c < 6; ++c) { float g[8]; *(f32x4*)&g[0] = *(const f32x4*)(gq + 64 * c + 8 * sl); *(f32x4*)&g[4] = *(const f32x4*)(gq + 64 * c + 8 * sl + 4);
#pragma unroll
              for (int e = 0; e < 8; ++e) v[c][e] *= rstd * g[e];
              st8f(CQN + (size_t)tok * QLORA + 64 * c + 8 * sl, v[c]); } }
        { float v[4][8]; float ss = 0.f;
#pragma unroll
          for (int c = 0; c < 4; ++c) { ld8f(z + 64 * (6 + c), v[c]);
#pragma unroll
              for (int e = 0; e < 8; ++e) ss += v[c][e] * v[c][e]; }
          const float rstd = 1.f / sqrtf(sum8lanes(ss) * (1.f / KVLORA) + EPS);
#pragma unroll
          for (int c = 0; c < 4; ++c) { float g[8]; *(f32x4*)&g[0] = *(const f32x4*)(gkv + 64 * c + 8 * sl); *(f32x4*)&g[4] = *(const f32x4*)(gkv + 64 * c + 8 * sl + 4);
#pragma unroll
              for (int e = 0; e < 8; ++e) v[c][e] *= rstd * g[e];
              st8f(CKVN + (size_t)tok * KVLORA + 64 * c + 8 * sl, v[c]); } }
        { float x[8]; ld8f(z + 640, x); const float pos = sl < 4 ? prow : pcol; const bool second = (sl & 2) != 0; const int lnk = lane_opaque();
#pragma unroll
          for (int e = 0; e < 8; ++e) { float sn, cs; sincos_hw(pos * f32_[e], sn, cs); const float y = shx(x[e], 2, lnk);
              x[e] = second ? (x[e] * cs + y * sn) : (x[e] * cs - y * sn); }
          st8f(KR + (size_t)tok * ROPE + 8 * sl, x);
          float ss = 0.f;
#pragma unroll
          for (int e = 0; e < 8; ++e) ss += x[e] * x[e];
          krmax = fmaxf(krmax, sum8lanes(ss)); }
        { float sr[8], cr[8], sc[8], cc[8];
#pragma unroll
          for (int e = 0; e < 8; ++e) { sincos_hw(prow * f64[e], sr[e], cr[e]); sincos_hw(pcol * f64[e], sc[e], cc[e]); }
#pragma unroll
          for (int h = 0; h < 4; ++h) head_norm_rope(z + 704 + 128 * h, gbq, QB + (size_t)tok * 512 + 128 * h + 8 * sl, sl, sr, cr, sc, cc);
#pragma unroll
          for (int h = 0; h < 2; ++h) head_norm_rope(z + 1216 + 128 * h, gbk, KB + (size_t)tok * 256 + 128 * h + 8 * sl, sl, sr, cr, sc, cc); }
    }
    { const int ln = lane_opaque(); krmax = fmaxf(krmax, shx(krmax, 8, ln)); krmax = fmaxf(krmax, shx(krmax, 16, ln)); krmax = fmaxf(krmax, shx(krmax, 32, ln)); }
    if (lane == 0) atomicMax((unsigned*)(ws + WS_SLOTS) + 64 * layer + 40, __float_as_uint(krmax));
}

#ifndef ATT_SD_MLA
#define ATT_SD_MLA 1
#endif
#ifndef ATT_SD_GQA
#define ATT_SD_GQA 2
#endif
__device__ __forceinline__ void phase_attn(const Params& p, int layer, char* lds, int G, int bid) {
    size_t wz_ = 0; asm volatile("" : "+s"(wz_)); unsigned char* ws = p.ws + wz_;
    const bf16_t* QA = (const bf16_t*)(ws + A_QA); const bf16_t* KVA = (const bf16_t*)(ws + A_KVA); const bf16_t* KR = (const bf16_t*)(ws + A_KR);
    const bf16_t* QB = (const bf16_t*)(ws + A_QB); const bf16_t* KB = (const bf16_t*)(ws + A_KB); const bf16_t* VB = (const bf16_t*)(ws + A_VB);
    bf16_t* O = (bf16_t*)(ws + A_O);
    bool gqa_nomax;
    { int tid_ = threadIdx.x; asm volatile("" : "+v"(tid_)); const int lane = tid_ & 63; const float* gq = p.in[8] + layer * HD; const float* gk = p.in[9] + layer * HD;
      float mq = fmaxf(fabsf(gq[lane]), fabsf(gq[64 + lane])), mk = fmaxf(fabsf(gk[lane]), fabsf(gk[64 + lane]));
#pragma unroll
      for (int o = 1; o < 64; o <<= 1) { mq = fmaxf(mq, shx(mq, o, lane)); mk = fmaxf(mk, shx(mk, o, lane)); }
      const float bound = 16.33f * 1.02f * mq * mk;
      gqa_nomax = __builtin_amdgcn_readfirstlane((int)(bound < 40.f)) != 0; }
    unsigned mla_nomax = 0u;
    { const unsigned* sl_ = (const unsigned*)(ws + WS_SLOTS) + 64 * layer;
      const float kr = __uint_as_float(__hip_atomic_load(sl_ + 40, __ATOMIC_RELAXED, __HIP_MEMORY_SCOPE_AGENT));
#pragma unroll
      for (int h = 0; h < 4; ++h) { float sq = 0.f, sk = kr;
#pragma unroll
          for (int g = 0; g < 6; ++g) sq += __uint_as_float(__hip_atomic_load(sl_ + h * 6 + g, __ATOMIC_RELAXED, __HIP_MEMORY_SCOPE_AGENT));
#pragma unroll
          for (int g = 0; g < 4; ++g) sk += __uint_as_float(__hip_atomic_load(sl_ + 24 + h * 4 + g, __ATOMIC_RELAXED, __HIP_MEMORY_SCOPE_AGENT));
          const float bound = 0.07216878364870323f * 1.4426950408889634f * 1.03f * sqrtf(sq * sk);
          if (bound < 80.f) mla_nomax |= 1u << h; }
      mla_nomax = (unsigned)__builtin_amdgcn_readfirstlane((int)mla_nomax); }
    for (int v = bid; v < 256; v += G) {
        const int xcd = v & 7, slot = v >> 3;
        for (int it = 0; it < 6; ++it) {
            const bool prompt = it < 4; const bool mla = prompt ? (it < 2) : (it == 4);
            int b, h, qb, seq; size_t tok0;
            if (prompt) { b = xcd >> 2; h = xcd & 3; qb = 2 * slot + (it & 1); seq = S_PROMPT; tok0 = (size_t)b * S_PROMPT; }
            else { const int combo = 2 * xcd + (slot >> 4); b = combo >> 2; h = combo & 3; qb = slot & 15; seq = S_SAMPLE; tok0 = (size_t)T_PROMPT + (size_t)b * S_SAMPLE; }
            const size_t i0 = tok0 + (size_t)qb * 256;
#ifndef NO_MLA
            if (mla) { if ((mla_nomax >> h) & 1u) att::attn_body<192, QA_W, KVA_W, KVA_W, DM, ATT_SD_MLA, true>(QA + i0 * QA_W + h * 192, KVA + tok0 * KVA_W + h * 256, KR + tok0 * ROPE, KVA + tok0 * KVA_W + h * 256 + 128,
                                                                    O + i0 * DM + h * 128, seq, qb * 256, lds);
                       else att::attn_body<192, QA_W, KVA_W, KVA_W, DM, ATT_SD_MLA, false>(QA + i0 * QA_W + h * 192, KVA + tok0 * KVA_W + h * 256, KR + tok0 * ROPE, KVA + tok0 * KVA_W + h * 256 + 128,
                                                                    O + i0 * DM + h * 128, seq, qb * 256, lds); }
#endif
#ifndef NO_GQA
            if (!mla) { if (gqa_nomax) att::attn_body<128, 512, 256, 256, DM, 1, true>(QB + i0 * 512 + h * 128, KB + tok0 * 256 + (h >> 1) * 128, nullptr, VB + tok0 * 256 + (h >> 1) * 128,
                                                                O + i0 * DM + 512 + h * 128, seq, qb * 256, lds);
                        else att::attn_body<128, 512, 256, 256, DM, ATT_SD_GQA, false>(QB + i0 * 512 + h * 128, KB + tok0 * 256 + (h >> 1) * 128, nullptr, VB + tok0 * 256 + (h >> 1) * 128,
                                                                O + i0 * DM + 512 + h * 128, seq, qb * 256, lds); }
#endif
        }
    }
}

constexpr int PH_PER_LAYER = 9, N_PHASES = DEPTH * PH_PER_LAYER + 1;

__global__ void __launch_bounds__(NWAVES * 64, 2) hymba_fwd(Params p) {
    extern __shared__ __attribute__((aligned(16))) unsigned char lds_raw[];
    LAS unsigned char* lds = (LAS unsigned char*)lds_raw;
    const int G = gridDim.x, bid = blockIdx.x, NGW = G * NWAVES;
#define FRESH() int tid_ = threadIdx.x; asm volatile("" : "+v"(tid_)); const int lane = tid_ & 63, wave = __builtin_amdgcn_readfirstlane(tid_ >> 6), gw = bid * NWAVES + wave; (void)lane; (void)gw
    const int lo = p.ph_lo, hi = p.ph_hi;
#define WSP() size_t wz_ = 0; asm volatile("" : "+s"(wz_)); unsigned char* ws = p.ws + wz_
#if MK_PER_PHASE
#define GRID_SYNC() do {} while (0)
#else
    cg::grid_group grid = cg::this_grid();
    volatile LAS unsigned* xbst = (volatile LAS unsigned*)(lds + LDS_XB);
    if (threadIdx.x < 4) xbst[threadIdx.x] = 0u;
    __syncthreads();
    XcdBarrier xbar = xcd_barrier_post((unsigned*)(p.ws + WS_BAR), xbst);
    bool first_sync = true;
#define GRID_SYNC() do { if (first_sync) { grid.sync(); first_sync = false; } else xcd_barrier(xbar); } while (0)
#endif
#ifdef TESTPH
#define IN(k) ((k) == TESTPH)
#else
#define IN(k) (lo <= (k) && (k) < hi)
#endif
#define SEAM(k) do { if (IN((k) + 1)) GRID_SYNC(); } while (0)
    const float* x_prompt = p.in[0]; const float* x_sample = p.in[1];
    float* X = p.out;


#ifdef TESTPH
#pragma unroll
#endif
    for (int layer = 0; layer < DEPTH; ++layer) {
        const int pb = layer * PH_PER_LAYER;
        if (IN(pb + 0)) {
            FRESH(); WSP();
            for (int rep = 0; rep < REP_THIN; ++rep) {
#ifndef NO_WT
            phase_weights(p, layer, lds, gw, NGW, wave, lane);
#endif
            if (layer == 0) phase_norm(x_prompt, x_sample, p.in[2] + layer * DM, (bf16_t*)(ws + A_H), gw, NGW, lane);
            else phase_norm_b16((const bf16_t*)X, p.in[2] + layer * DM, (bf16_t*)(ws + A_H), gw, NGW, lane);
            __syncthreads();
            }
            SEAM(pb + 0);
        }
        if (IN(pb + 1)) {
            WSP();
            pg8::Gemm g{(const bf16_t*)(ws + A_H), (const bf16_t*)(ws + W_IN), T, INW_PAD, DM}; pg8::StaticOrder S; S.init(T, INW_PAD, G, bid);
            pg8::EpiZ E{(bf16_t*)(ws + A_Z), (bf16_t*)(ws + A_VB), nullptr};
#ifndef NO_GEMM
            pg8::gemm_phase(lds, g, S, E);
#endif
            SEAM(pb + 1);
        }
        if (IN(pb + 2)) {
            FRESH();
#ifndef NO_POST
            for (int rep = 0; rep < REP_THIN; ++rep) phase_post(p, layer, gw, NGW, lane);
#endif
            SEAM(pb + 2); }
        if (IN(pb + 3)) {
            WSP();
            { pg8::Gemm g{(const bf16_t*)(ws + A_CQN), (const bf16_t*)(ws + W_Q), T, QA_W, QLORA}; pg8::StaticOrder S; S.init(T, QA_W, G, bid);
              pg8::EpiBf16Norm E{(bf16_t*)(ws + A_QA), QA_W, (unsigned*)(ws + WS_SLOTS) + 64 * layer, 0};
#ifndef NO_GEMM
              pg8::gemm_phase(lds, g, S, E);
#endif
            }
            { pg8::Gemm g{(const bf16_t*)(ws + A_CKVN), (const bf16_t*)(ws + W_KV), T, KVA_W, KVLORA}; pg8::StaticOrder S; S.init(T, KVA_W, G, bid);
              pg8::EpiBf16Norm E{(bf16_t*)(ws + A_KVA), KVA_W, (unsigned*)(ws + WS_SLOTS) + 64 * layer, 1};
#ifndef NO_GEMM
              pg8::gemm_phase(lds, g, S, E);
#endif
            }
            SEAM(pb + 3);
        }
        if (IN(pb + 4)) {
#ifndef NO_ATTN
            for (int rep = 0; rep < REP_ATTN; ++rep) phase_attn(p, layer, (char*)lds_raw, G, bid);
#endif
            SEAM(pb + 4); }
        if (IN(pb + 5)) {
            WSP();
            pg8::Gemm g{(const bf16_t*)(ws + A_O), (const bf16_t*)(ws + W_O), T, DM, DM}; pg8::StaticOrder S; S.init(T, DM, G, bid);
            if (layer == 0) { pg8::EpiResB16<true> E{(bf16_t*)X, x_prompt, x_sample, T_PROMPT, DM, nullptr, (float*)(ws + WS_RS)}; pg8::gemm_phase(lds, g, S, E); }
            else { pg8::EpiResB16<false> E{(bf16_t*)X, X, nullptr, 0, DM, nullptr, (float*)(ws + WS_RS)}; pg8::gemm_phase(lds, g, S, E); }
            SEAM(pb + 5);
        }
        if (IN(pb + 7)) {
            WSP();
            pg8::Gemm g{(const bf16_t*)X, (const bf16_t*)(ws + W_UP), T, DFF, DM}; pg8::StaticOrder S; S.init(T, DFF, G, bid);
            pg8::EpiBf16<1> E{(bf16_t*)(ws + A_U), DFF, nullptr};
#ifndef NO_GEMM
            pg8::gemm_phase(lds, g, S, E);
#endif
            SEAM(pb + 7);
        }
        if (IN(pb + 8)) {
            WSP();
            pg8::Gemm g{(const bf16_t*)(ws + A_U), (const bf16_t*)(ws + W_DN), T, DM, DFF}; pg8::StaticOrder S; S.init(T, DM, G, bid);
            pg8::EpiResB16<false> E{layer == DEPTH - 1 ? (bf16_t*)(ws + A_H2) : (bf16_t*)X, X, nullptr, 0, DM, (const float*)(ws + WS_RS), nullptr};
#ifndef NO_GEMM
            pg8::gemm_phase(lds, g, S, E);
#endif
            SEAM(pb + 8);
        }
    }
    if (IN(N_PHASES - 1)) { FRESH(); WSP(); phase_final_norm_b16((const bf16_t*)(ws + A_H2), X, p.in[14], gw, NGW, lane); }
#undef IN
#undef SEAM
#undef GRID_SYNC
}

extern "C" void kernel_launch(void* const* d_in, const int* in_sizes, int n_in, void* d_out, int out_size, void* d_ws, size_t ws_size, hipStream_t stream) {
    static int grid = 0;
    if (grid == 0) {
        if (n_in != 15 || out_size != T * DM || ws_size < WS_TOTAL) {
            fprintf(stderr, "kernel_launch: shape mismatch: n_in %d out %d ws %zu (need %zu)\n", n_in, out_size, ws_size, (size_t)WS_TOTAL); grid = -1; return; }
        int dev = 0, cus = 0, per_cu = 0;
        if (hipGetDevice(&dev) != hipSuccess || hipDeviceGetAttribute(&cus, hipDeviceAttributeMultiprocessorCount, dev) != hipSuccess) { fprintf(stderr, "kernel_launch: device query failed\n"); grid = -1; return; }
        if (hipFuncSetAttribute((const void*)hymba_fwd, hipFuncAttributeMaxDynamicSharedMemorySize, LDS_BYTES) != hipSuccess) { fprintf(stderr, "kernel_launch: hipFuncSetAttribute failed\n"); grid = -1; return; }
        if (hipOccupancyMaxActiveBlocksPerMultiprocessor(&per_cu, (const void*)hymba_fwd, NWAVES * 64, LDS_BYTES) != hipSuccess || per_cu < 1) {
            fprintf(stderr, "kernel_launch: occupancy query reports %d workgroups per CU\n", per_cu); per_cu = 1; }
        (void)hipGetLastError();
        grid = cus;
        if (grid > 256) grid = 256;
    }
    if (grid < 0) return;
    Params p{};
    for (int i = 0; i < 15; ++i) p.in[i] = (const float*)d_in[i];
    p.out = (float*)d_out; p.ws = (unsigned char*)d_ws;
#if !MK_PER_PHASE
    if (hipMemsetAsync((char*)d_ws + WS_BAR, 0, 16384, stream) != hipSuccess) { fprintf(stderr, "kernel_launch: memset of the barrier words failed\n"); return; }
#endif
#if MK_PER_PHASE
    for (int ph = 0; ph < N_PHASES; ++ph) {
        p.ph_lo = ph; p.ph_hi = ph + 1;
        hipLaunchKernelGGL(hymba_fwd, dim3(grid), dim3(NWAVES * 64), LDS_BYTES, stream, p);
    }
#else
    p.ph_lo = 0; p.ph_hi = N_PHASES;
    void* args[] = {&p};
    hipError_t e = hipLaunchCooperativeKernel((const void*)hymba_fwd, dim3(grid), dim3(NWAVES * 64), args, LDS_BYTES, stream);
    if (e != hipSuccess) fprintf(stderr, "kernel_launch: cooperative launch failed: %s (grid %d)\n", hipGetErrorString(e), grid);
#endif
}
```
